# Optimizing an MI355X kernel written in HIP

```python
import math
import jax, jax.numpy as jnp
from jax import lax
import numpy as np

D_MODEL = 1024
BATCH = 32
SEQ = 2048
DEPTH = 4

N_MIXERS = 3
HEAD_DIM = 64
N_HEADS = D_MODEL // (2 * HEAD_DIM)
Q_BLOCK = 128
ROPE_THETA = 10000.0
GMLP_WIDTH = 3 * D_MODEL // 2
GMLP_GROUPS = 8
GMLP_GW = GMLP_WIDTH // GMLP_GROUPS
CHUNK = 128
CONV_WIDTH = 3
D_FF = ((8 * D_MODEL + 3 * 256 - 1) // (3 * 256)) * 256
NORM_EPS = 1e-6
SUBLN_EPS = 1e-5
LN_EPS = 1e-5
NEG_INF = -1e30

kernel_name = "hybrid_diffattn_gmlp_shortconv_trunk"


def n_layers_of(kind):
    return len(range(kind, DEPTH, N_MIXERS))


def rms_norm(x, g, eps=NORM_EPS):
    xf = x.astype(jnp.float32)
    y = xf * lax.rsqrt(jnp.mean(xf * xf, axis=-1, keepdims=True) + eps)
    return (y * g.astype(jnp.float32)).astype(x.dtype)


def layer_norm(x, g, b, eps=LN_EPS):
    xf = x.astype(jnp.float32)
    mu = jnp.mean(xf, axis=-1, keepdims=True)
    var = jnp.mean(jnp.square(xf - mu), axis=-1, keepdims=True)
    y = (xf - mu) * lax.rsqrt(var + eps)
    return (y * g.astype(jnp.float32) + b.astype(jnp.float32)).astype(x.dtype)


def rope_tables(positions):
    inv_freq = 1.0 / (ROPE_THETA ** (jnp.arange(0, HEAD_DIM, 2, dtype=jnp.float32) / HEAD_DIM))
    ang = positions.astype(jnp.float32)[..., None] * inv_freq
    return jnp.cos(ang)[:, :, None, :], jnp.sin(ang)[:, :, None, :]


def apply_rope(x, cos, sin):
    xf = x.astype(jnp.float32)
    x1, x2 = jnp.split(xf, 2, axis=-1)
    return jnp.concatenate([x1 * cos - x2 * sin, x2 * cos + x1 * sin], axis=-1).astype(x.dtype)


def diff_attention(h, cos, sin, w_in, lam, subln, w_out, lambda_init):
    B, S, _ = h.shape
    q, k, v = jnp.split(h @ w_in, 3, axis=-1)
    q = apply_rope(q.reshape(B, S, 2 * N_HEADS, HEAD_DIM), cos, sin) * (HEAD_DIM ** -0.5)
    k = apply_rope(k.reshape(B, S, 2 * N_HEADS, HEAD_DIM), cos, sin)
    v = v.reshape(B, S, N_HEADS, 2 * HEAD_DIM)
    lamf = lam.astype(jnp.float32)
    lam_full = (jnp.exp(jnp.sum(lamf[0] * lamf[1])) - jnp.exp(jnp.sum(lamf[2] * lamf[3]))
                + lambda_init)
    outs = []
    for i in range(S // Q_BLOCK):
        kv_len = (i + 1) * Q_BLOCK
        qb = q[:, i * Q_BLOCK:kv_len]
        kb = k[:, :kv_len]
        vb = v[:, :kv_len]
        s = jnp.einsum('bqmd,bkmd->bmqk', qb, kb, preferred_element_type=jnp.float32)
        qpos = i * Q_BLOCK + jnp.arange(Q_BLOCK)
        mask = jnp.arange(kv_len)[None, :] <= qpos[:, None]
        p = jax.nn.softmax(jnp.where(mask, s, NEG_INF), axis=-1)
        p = p.reshape(B, N_HEADS, 2, Q_BLOCK, kv_len)
        a = p[:, :, 0] - lam_full * p[:, :, 1]
        outs.append(jnp.einsum('bhqk,bkhe->bqhe', a.astype(vb.dtype), vb))
    o = jnp.concatenate(outs, axis=1)
    o = rms_norm(o, subln, SUBLN_EPS) * (1.0 - lambda_init)
    return o.reshape(B, S, D_MODEL) @ w_out


def chunked_gmlp(h, w_in, b_in, ln_g, ln_b, w_s, b_s, w_out):
    B, S, _ = h.shape
    z = jax.nn.gelu(h @ w_in + b_in, approximate=False)
    u, v = jnp.split(z, 2, axis=-1)
    v = layer_norm(v, ln_g, ln_b).reshape(B, S // CHUNK, CHUNK, GMLP_GROUPS, GMLP_GW)
    causal = jnp.tril(jnp.ones((CHUNK, CHUNK), dtype=w_s.dtype))
    ws = w_s * causal[None]
    sv = jnp.einsum('gts,bnsgc->bntgc', ws, v) + b_s.T[None, None, :, :, None]
    return (u * sv.reshape(B, S, GMLP_WIDTH)) @ w_out


def short_conv(h, w_in, conv_w, w_out):
    gb, gc, xs = jnp.split(h @ w_in, 3, axis=-1)
    hc = gc * xs
    conv = lax.conv_general_dilated(
        hc, conv_w[:, None, :], window_strides=(1,), padding=[(CONV_WIDTH - 1, 0)],
        dimension_numbers=('NWC', 'WIO', 'NWC'), feature_group_count=D_MODEL)
    return (gb * conv) @ w_out


def swiglu(h, w_gate_up, w_down):
    g, u = jnp.split(h @ w_gate_up, 2, axis=-1)
    return (jax.nn.silu(g) * u) @ w_down


def setup_inputs(seed: int = 0) -> dict:
    key = jax.random.key(seed)
    ks = jax.random.split(key, 24)
    nA, nB, nC = n_layers_of(0), n_layers_of(1), n_layers_of(2)
    D = D_MODEL
    nrm = lambda k, shape, scale: jax.random.normal(k, shape, jnp.float32) * scale
    offset = jax.random.randint(ks[1], (BATCH, 1), 0, 4096, dtype=jnp.int32)
    return {
        "x": jax.random.normal(ks[0], (BATCH, SEQ, D), jnp.float32),
        "positions": offset + jnp.arange(SEQ, dtype=jnp.int32)[None, :],
        "mix_norm": 1.0 + nrm(ks[2], (DEPTH, D), 0.02),
        "ffn_norm": 1.0 + nrm(ks[3], (DEPTH, D), 0.02),
        "final_norm": 1.0 + nrm(ks[4], (D,), 0.02),
        "attn_w_in": nrm(ks[5], (nA, D, 3 * D), D ** -0.5),
        "attn_lambda": nrm(ks[6], (nA, 4, HEAD_DIM), 0.1),
        "attn_subln": 1.0 + nrm(ks[7], (nA, 2 * HEAD_DIM), 0.02),
        "attn_w_out": nrm(ks[8], (nA, D, D), D ** -0.5),
        "gmlp_w_in": nrm(ks[9], (nB, D, 2 * GMLP_WIDTH), D ** -0.5),
        "gmlp_b_in": nrm(ks[10], (nB, 2 * GMLP_WIDTH), 0.02),
        "gmlp_ln_g": 1.0 + nrm(ks[11], (nB, GMLP_WIDTH), 0.02),
        "gmlp_ln_b": nrm(ks[12], (nB, GMLP_WIDTH), 0.02),
        "gmlp_w_s": nrm(ks[13], (nB, GMLP_GROUPS, CHUNK, CHUNK), CHUNK ** -0.5),
        "gmlp_b_s": 1.0 + nrm(ks[14], (nB, GMLP_GROUPS, CHUNK), 0.02),
        "gmlp_w_out": nrm(ks[15], (nB, GMLP_WIDTH, D), GMLP_WIDTH ** -0.5),
        "conv_w_in": nrm(ks[16], (nC, D, 3 * D), D ** -0.5),
        "conv_w": nrm(ks[17], (nC, CONV_WIDTH, D), CONV_WIDTH ** -0.5),
        "conv_w_out": nrm(ks[18], (nC, D, D), D ** -0.5),
        "ffn_w_gate_up": nrm(ks[19], (DEPTH, D, 2 * D_FF), D ** -0.5),
        "ffn_w_down": nrm(ks[20], (DEPTH, D_FF, D), D_FF ** -0.5),
    }


def reference(x, positions, mix_norm, ffn_norm, final_norm,
              attn_w_in, attn_lambda, attn_subln, attn_w_out,
              gmlp_w_in, gmlp_b_in, gmlp_ln_g, gmlp_ln_b, gmlp_w_s, gmlp_b_s, gmlp_w_out,
              conv_w_in, conv_w, conv_w_out,
              ffn_w_gate_up, ffn_w_down):
    cos, sin = rope_tables(positions)
    for i in range(DEPTH):
        kind, j = i % N_MIXERS, i // N_MIXERS
        h = rms_norm(x, mix_norm[i])
        if kind == 0:
            lambda_init = 0.8 - 0.6 * math.exp(-0.3 * i)
            m = diff_attention(h, cos, sin, attn_w_in[j], attn_lambda[j], attn_subln[j],
                               attn_w_out[j], lambda_init)
        elif kind == 1:
            m = chunked_gmlp(h, gmlp_w_in[j], gmlp_b_in[j], gmlp_ln_g[j], gmlp_ln_b[j],
                             gmlp_w_s[j], gmlp_b_s[j], gmlp_w_out[j])
        else:
            m = short_conv(h, conv_w_in[j], conv_w[j], conv_w_out[j])
        x = x + m
        x = x + swiglu(rms_norm(x, ffn_norm[i]), ffn_w_gate_up[i], ffn_w_down[i])
    return rms_norm(x, final_norm)
```

```cpp
#include <hip/hip_runtime.h>
#include <hip/hip_cooperative_groups.h>
#include <cstdio>
#include <cstdint>
#include <cmath>
namespace pg8 {
#define PG8_LAS __attribute__((address_space(3)))
typedef unsigned short bf16_t;
typedef short bf16x8 __attribute__((ext_vector_type(8)));
typedef float f32x4 __attribute__((ext_vector_type(4)));
typedef unsigned u32x4 __attribute__((ext_vector_type(4)));
constexpr int BM = 256, BK = 64, HALF = 128, HTB = HALF * BK * 2  , STAGE_BYTES = 8 * HTB, NXCD = 8, WGM = 8;

__host__ __device__ __forceinline__ int lds_byte(int r, int c) { const int st = (r >> 4) * 2 + (c >> 5), rr = r & 15, cc = c & 31, ob = rr * 64 + cc * 2; return st * 1024 + (ob ^ (((ob >> 9) & 1) << 5)); }
__host__ __device__ __forceinline__ void stage_rc(int b, int& R, int& C) { const int st = b / 1024, sb = b % 1024, swz = sb ^ (((sb >> 9) & 1) << 5); R = (st >> 1) * 16 + swz / 64; C = (st & 1) * 32 + (swz % 64) / 2; }
__host__ __device__ __forceinline__ int perm32(int rho) { const int n = rho >> 4, i = rho & 15; return 8 * (i >> 2) + 4 * n + (i & 3); }

struct Unit { int pm, pn; };
struct Gemm { const bf16_t* A; const bf16_t* Bt; int M, N, K; };

struct StaticOrder {
    int nM, nN, nwg, G, c;
    __host__ __device__ void init(int M, int N, int G_, int c_) { nM = M / BM; nN = N / BM; nwg = nM * nN; G = G_; c = c_; }
    __host__ __device__ bool next(int i, Unit& u) const {
        const long L = (long)i * G + c; if (L >= nwg) return false;
        int wgid = (int)L; { const int q = nwg / NXCD, r = nwg % NXCD, xcd = wgid % NXCD, off = wgid / NXCD; wgid = (xcd < r ? xcd * (q + 1) : r * (q + 1) + (xcd - r) * q) + off; }
        const int nig = WGM * nN, gid = wgid / nig, fm = gid * WGM, gsz = (nM - fm) < WGM ? (nM - fm) : WGM;
        u.pm = fm + ((wgid % nig) % gsz); u.pn = (wgid % nig) / gsz; return true;
    }
    __device__ __forceinline__ void a_ready(const Unit&) const {}
    __device__ __forceinline__ void done(const Unit&) const {}
};
__device__ __forceinline__ unsigned cvt_pk_bf16(float lo, float hi) { unsigned r; asm volatile("v_cvt_pk_bf16_f32 %0, %1, %2" : "=v"(r) : "v"(lo), "v"(hi)); return r; }
typedef float f32x2 __attribute__((ext_vector_type(2)));
__device__ __forceinline__ f32x2 gelu_pk(f32x2 v) {
    const f32x2 av = __builtin_elementwise_abs(v), d = av * 0.2316418882f + 1.0f;
    f32x2 t; t.x = __builtin_amdgcn_rcpf(d.x); t.y = __builtin_amdgcn_rcpf(d.y);
    f32x2 q = t * 0.5307027145f + (-0.7265760135f); q = q * t + 0.7107068705f; q = q * t + (-0.142248368f); q = q * t + 0.127414796f; q = q * t;
    const f32x2 s = (v * v) * (-0.72134752044f);
    f32x2 e; e.x = __builtin_amdgcn_exp2f(s.x); e.y = __builtin_amdgcn_exp2f(s.y);
    const f32x2 m = v * (q * e), r = v - m;
    f32x2 o; o.x = v.x < 0.f ? m.x : r.x; o.y = v.y < 0.f ? m.y : r.y; return o;
}
constexpr float QK_C2 = 0.125f * 1.4426950408889634f;
typedef float f32x2e __attribute__((ext_vector_type(2)));
__device__ __forceinline__ u32x4 pack8(const f32x4 a, const f32x4 b) { u32x4 w; w.x = cvt_pk_bf16(a[0], a[1]); w.y = cvt_pk_bf16(a[2], a[3]); w.z = cvt_pk_bf16(b[0], b[1]); w.w = cvt_pk_bf16(b[2], b[3]); return w; }
__device__ __forceinline__ float quad_sum(float s) { s += __shfl_xor(s, 16); s += __shfl_xor(s, 32); return s; }
struct EpiGen {
    static constexpr bool PERM = true, AFTER_DRAIN = false;
    int mode;
    float* ssq;
    float eps;
    bf16_t *o0, *o1, *o2;
    const f32x4* rope;
    const float* bias;
    f32x2e* vstat;
    const float* xin; float* xout;
    __device__ __forceinline__ float row_rstd(int row, int fq) const {
        const f32x4 p = *(const f32x4*)(ssq + (size_t)row * 16 + fq * 4);
        const float s = quad_sum((p[0] + p[1]) + (p[2] + p[3]));
        return __builtin_amdgcn_rsqf(s * (1.0f / 1024.0f) + eps);
    }
    __device__ __forceinline__ void operator()(const f32x4 (&acc)[2][2][4][2], const Unit& u, int wr, int wc, int fr, int fq) const {
        const int rowb = u.pm * BM + wr * 64 + fr, pn = u.pn;
        if (mode == 3) {
            const int col0 = pn * BM + wc * 32 + 8 * fq;
#pragma unroll
            for (int ai = 0; ai < 2; ++ai)
#pragma unroll
                for (int m = 0; m < 4; ++m) {
                    const int row = rowb + ai * HALF + m * 16; const size_t off = (size_t)row * 1024 + col0; float sq = 0.f;
#pragma unroll
                    for (int bj = 0; bj < 2; ++bj) {
                        const f32x4 x0 = *(const f32x4*)(xin + off + bj * HALF), x1 = *(const f32x4*)(xin + off + bj * HALF + 4);
                        const f32x4 v0 = x0 + acc[ai][bj][m][0], v1 = x1 + acc[ai][bj][m][1];
                        *(f32x4*)(xout + off + bj * HALF) = v0; *(f32x4*)(xout + off + bj * HALF + 4) = v1;
                        sq += (v0[0] * v0[0] + v0[1] * v0[1]) + (v0[2] * v0[2] + v0[3] * v0[3]) + (v1[0] * v1[0] + v1[1] * v1[1]) + (v1[2] * v1[2] + v1[3] * v1[3]);
                        if (o0) *(u32x4*)(o0 + off + bj * HALF) = pack8(v0, v1);
                    }
                    sq = quad_sum(sq);
                    if (fq == 0) ssq[(size_t)row * 16 + pn * 4 + wc] = sq;
                    if (m & 1) asm volatile("" ::: "memory");
                }
        } else if (mode == 4) {
            const int col0 = pn * HALF + wc * 32 + 8 * fq;
#pragma unroll
            for (int ai = 0; ai < 2; ++ai)
#pragma unroll
                for (int m = 0; m < 4; ++m) {
                    const int row = rowb + ai * HALF + m * 16; const float rs = row_rstd(row, fq); f32x4 h[2];
#pragma unroll
                    for (int n = 0; n < 2; ++n) {
                        const f32x4 g = acc[ai][0][m][n] * rs, uu = acc[ai][1][m][n] * rs;
#pragma unroll
                        for (int e = 0; e < 4; ++e) h[n][e] = g[e] * uu[e] * __builtin_amdgcn_rcpf(1.0f + __builtin_amdgcn_exp2f(g[e] * -1.4426950408889634f));
                    }
                    *(u32x4*)(o0 + (size_t)row * 2816 + col0) = pack8(h[0], h[1]);
                }
        } else if (mode == 0) {
            if (pn < 8) {
                bf16_t* dst = (pn < 4) ? o0 : o1; const float sc = (pn < 4) ? QK_C2 : 1.0f; const int head = (pn & 3) * 4 + wc;
#pragma unroll
                for (int ai = 0; ai < 2; ++ai)
#pragma unroll
                    for (int m = 0; m < 4; ++m) {
                        const int row = rowb + ai * HALF + m * 16; const float rs = row_rstd(row, fq) * sc;
                        const f32x4* cs = rope + (size_t)row * 16 + 4 * fq;
                        const f32x4 t0 = cs[0], t1 = cs[1], t2 = cs[2], t3 = cs[3];
                        const f32x4 ca = (f32x4){t0[0], t0[2], t1[0], t1[2]}, sa = (f32x4){t0[1], t0[3], t1[1], t1[3]}, cb = (f32x4){t2[0], t2[2], t3[0], t3[2]}, sb = (f32x4){t2[1], t2[3], t3[1], t3[3]};
                        const f32x4 x1a = acc[ai][0][m][0] * rs, x1b = acc[ai][0][m][1] * rs, x2a = acc[ai][1][m][0] * rs, x2b = acc[ai][1][m][1] * rs;
                        const f32x4 o1a = x1a * ca - x2a * sa, o1b = x1b * cb - x2b * sb, o2a = x2a * ca + x1a * sa, o2b = x2b * cb + x1b * sb;
                        bf16_t* p = dst + (size_t)row * 1024 + head * 64 + 8 * fq;
                        *(u32x4*)p = pack8(o1a, o1b); *(u32x4*)(p + 32) = pack8(o2a, o2b);
                    }
            } else {
                const int col0 = (pn - 8) * BM + wc * 32 + 8 * fq;
#pragma unroll
                for (int ai = 0; ai < 2; ++ai)
#pragma unroll
                    for (int m = 0; m < 4; ++m) {
                        const int row = rowb + ai * HALF + m * 16; const float rs = row_rstd(row, fq);
#pragma unroll
                        for (int bj = 0; bj < 2; ++bj) *(u32x4*)(o2 + (size_t)row * 1024 + col0 + bj * HALF) = pack8(acc[ai][bj][m][0] * rs, acc[ai][bj][m][1] * rs);
                    }
            }
        } else if (mode == 1) {
            const int col0 = pn * BM + wc * 32 + 8 * fq; const bool isv = pn >= 6;
            bf16_t* dst = isv ? (o1 + col0 - 1536) : (o0 + col0);
            f32x4 bv[2][2];
#pragma unroll
            for (int bj = 0; bj < 2; ++bj)
#pragma unroll
                for (int n = 0; n < 2; ++n) bv[bj][n] = *(const f32x4*)(bias + col0 + bj * HALF + 4 * n);
#pragma unroll
            for (int ai = 0; ai < 2; ++ai)
#pragma unroll
                for (int m = 0; m < 4; ++m) {
                    const int row = rowb + ai * HALF + m * 16; const float rs = row_rstd(row, fq); float s1 = 0.f, s2 = 0.f;
#pragma unroll
                    for (int bj = 0; bj < 2; ++bj) {
                        f32x4 v0 = acc[ai][bj][m][0] * rs + bv[bj][0], v1 = acc[ai][bj][m][1] * rs + bv[bj][1];
                        const f32x2 a = gelu_pk((f32x2){v0[0], v0[1]}), b = gelu_pk((f32x2){v0[2], v0[3]}), c = gelu_pk((f32x2){v1[0], v1[1]}), d = gelu_pk((f32x2){v1[2], v1[3]});
                        v0 = (f32x4){a.x, a.y, b.x, b.y}; v1 = (f32x4){c.x, c.y, d.x, d.y};
                        s1 += ((v0[0] + v0[1]) + (v0[2] + v0[3])) + ((v1[0] + v1[1]) + (v1[2] + v1[3]));
                        s2 += (v0[0] * v0[0] + v0[1] * v0[1]) + (v0[2] * v0[2] + v0[3] * v0[3]) + (v1[0] * v1[0] + v1[1] * v1[1]) + (v1[2] * v1[2] + v1[3] * v1[3]);
                        *(u32x4*)(dst + (size_t)row * 1536 + bj * HALF) = pack8(v0, v1);
                    }
                    if (isv) { s1 = quad_sum(s1); s2 = quad_sum(s2); if (fq == 0) vstat[(size_t)row * 24 + (pn - 6) * 4 + wc] = (f32x2e){s1, s2}; }
                }
        } else {
#pragma unroll
            for (int ai = 0; ai < 2; ++ai)
#pragma unroll
                for (int m = 0; m < 4; ++m) {
                    const int row = rowb + ai * HALF + m * 16; const float rs = row_rstd(row, fq);
                    if (pn < 4) {
#pragma unroll
                        for (int bj = 0; bj < 2; ++bj) *(u32x4*)(o0 + (size_t)row * 1024 + pn * BM + wc * 32 + 8 * fq + bj * HALF) = pack8(acc[ai][bj][m][0] * rs, acc[ai][bj][m][1] * rs);
                    } else {
                        const float r2 = rs * rs;
                        *(u32x4*)(o1 + (size_t)row * 1024 + (pn - 4) * HALF + wc * 32 + 8 * fq) = pack8(acc[ai][0][m][0] * acc[ai][1][m][0] * r2, acc[ai][0][m][1] * acc[ai][1][m][1] * r2);
                    }
                }
        }
    }
};

template <class Epi, class Sched, bool ALIGN_EPI = false, bool SP2 = false>
__device__ __forceinline__ void gemm_phase(PG8_LAS unsigned char* lds, const Gemm g, const Sched& S, const Epi& E, const int tid) {
    const int wid = __builtin_amdgcn_readfirstlane(tid >> 6), lane = tid & 63, wr = wid >> 2, wc = wid & 3, fr = lane & 15, fq = lane >> 4;
    const int K = g.K, nt = K / BK;
    unsigned voffA[2], voffB[2];
#pragma unroll
    for (int i = 0; i < 2; ++i) { int R, C; stage_rc(tid * 16 + i * 8192, R, C); const int Rb = Epi::PERM ? ((R & ~31) + perm32(R & 31)) : R;
        voffA[i] = (unsigned)(R * K + C) * 2u; voffB[i] = (unsigned)(Rb * K + C) * 2u; }
    const size_t kstep = (size_t)(BK * 2);
    const size_t hstep = (size_t)HALF * K * 2;
    const size_t tstep = 2 * hstep;
    const unsigned ldsw = (unsigned)wid * 1024u;
    const int aoff = lds_byte(wr * 64 + fr, fq * 8), boff = lds_byte(wc * 32 + fr, fq * 8);
#define PG8_SA(b, h) (((b) * 2 + (h)) * HTB)
#define PG8_SB(b, h) ((4 + (b) * 2 + (h)) * HTB)
#define PG8_STAGE(bufoff, gbase, voff) do { _Pragma("unroll") for (int _i = 0; _i < 2; ++_i) \
        __builtin_amdgcn_global_load_lds((const unsigned*)((const char*)(gbase) + (voff)[_i]), (PG8_LAS unsigned*)(lds + (bufoff) + ldsw + _i * 8192), 16, 0, 0); } while (0)
#define PG8_LDA(dst, b, h) do { _Pragma("unroll") for (int m = 0; m < 4; ++m) _Pragma("unroll") for (int k = 0; k < 2; ++k) dst[m][k] = *(const PG8_LAS bf16x8*)(lds + PG8_SA(b, h) + aoff + m * 2048 + k * 1024); } while (0)
#define PG8_LDB(dst, b, h) do { _Pragma("unroll") for (int n = 0; n < 2; ++n) _Pragma("unroll") for (int k = 0; k < 2; ++k) dst[n][k] = *(const PG8_LAS bf16x8*)(lds + PG8_SB(b, h) + boff + n * 2048 + k * 1024); } while (0)
#define PG8_MMA(ai, bj, At, Bt) do { __builtin_amdgcn_s_setprio(1); _Pragma("unroll") for (int m = 0; m < 4; ++m) _Pragma("unroll") for (int n = 0; n < 2; ++n) _Pragma("unroll") for (int k = 0; k < 2; ++k) \
        acc[ai][bj][m][n] = __builtin_amdgcn_mfma_f32_16x16x32_bf16(Bt[n][k], At[m][k], acc[ai][bj][m][n], 0, 0, 0); __builtin_amdgcn_s_setprio(0); } while (0)
#define PG8_WAIT_V(n) asm volatile("s_waitcnt vmcnt(" #n ")" ::: "memory")
#define PG8_WAIT_L(n) asm volatile("s_waitcnt lgkmcnt(" #n ")" ::: "memory")
#define PG8_BAR __builtin_amdgcn_s_barrier()
#define PG8_SCHED __builtin_amdgcn_sched_barrier(0)
    Unit cur, nxt; int ui = 0;
    if (!S.next(0, cur)) return;
    f32x4 acc[2][2][4][2];
#pragma unroll
    for (int a = 0; a < 2; ++a)
#pragma unroll
        for (int b = 0; b < 2; ++b)
#pragma unroll
            for (int m = 0; m < 4; ++m)
#pragma unroll
                for (int n = 0; n < 2; ++n) acc[a][b][m][n] = (f32x4){0.f, 0.f, 0.f, 0.f};
    bf16x8 At[4][2], B0[2][2], B1[2][2];
    const char* cA = (const char*)g.A + (size_t)cur.pm * tstep; const char* cB = (const char*)g.Bt + (size_t)cur.pn * tstep;
    S.a_ready(cur);
    if constexpr (SP2) {
        PG8_STAGE(PG8_SB(0, 0), cB, voffB); PG8_STAGE(PG8_SB(0, 1), cB + hstep, voffB); PG8_STAGE(PG8_SA(0, 0), cA, voffA); PG8_STAGE(PG8_SA(0, 1), cA + hstep, voffA);
        if (wr == 1) PG8_BAR;
        PG8_WAIT_V(2); PG8_BAR;
        PG8_STAGE(PG8_SB(1, 0), cB + kstep, voffB); PG8_STAGE(PG8_SA(1, 0), cA + kstep, voffA); PG8_STAGE(PG8_SB(1, 1), cB + hstep + kstep, voffB);
        PG8_WAIT_V(6); PG8_BAR;
    } else {
        PG8_STAGE(PG8_SB(0, 0), cB, voffB); PG8_STAGE(PG8_SA(0, 0), cA, voffA); PG8_STAGE(PG8_SB(0, 1), cB + hstep, voffB); PG8_STAGE(PG8_SA(0, 1), cA + hstep, voffA);
        if (wr == 1) PG8_BAR;
        PG8_WAIT_V(4); PG8_BAR;
        PG8_STAGE(PG8_SB(1, 0), cB + kstep, voffB); PG8_STAGE(PG8_SA(1, 0), cA + kstep, voffA); PG8_STAGE(PG8_SB(1, 1), cB + hstep + kstep, voffB);
        PG8_WAIT_V(6); PG8_BAR;
    }
    for (;;) {
        const bool has_next = S.next(ui + 1, nxt);
        const char* nA = has_next ? (const char*)g.A + (size_t)nxt.pm * tstep : cA; const char* nB = has_next ? (const char*)g.Bt + (size_t)nxt.pn * tstep : cB;
        for (int t = 0; t < nt; t += 2) {
            const bool last = (t == nt - 2);
            const char* a1 = cA + (size_t)(t + 1) * kstep;
            const char* a2 = last ? nA : cA + (size_t)(t + 2) * kstep; const char* b2 = last ? nB : cB + (size_t)(t + 2) * kstep;
            const char* a3 = a2 + kstep; const char* b3 = b2 + kstep;
            if (last && has_next) S.a_ready(nxt);
            if constexpr (SP2) {
            PG8_LDB(B0, 0, 0); PG8_LDB(B1, 0, 1); PG8_SCHED; PG8_LDA(At, 0, 0); PG8_STAGE(PG8_SA(1, 1), a1 + hstep, voffA);
            PG8_WAIT_V(8); PG8_WAIT_L(0); PG8_BAR; PG8_MMA(0, 0, At, B0); PG8_MMA(0, 1, At, B1); PG8_BAR; PG8_SCHED;
            PG8_LDA(At, 0, 1); PG8_STAGE(PG8_SB(0, 0), b2, voffB); PG8_STAGE(PG8_SB(0, 1), b2 + hstep, voffB); PG8_STAGE(PG8_SA(0, 0), a2, voffA);
            PG8_WAIT_V(8); PG8_WAIT_L(0); PG8_BAR; PG8_MMA(1, 0, At, B0); PG8_MMA(1, 1, At, B1); PG8_BAR; PG8_SCHED;
            PG8_LDB(B0, 1, 0); PG8_LDB(B1, 1, 1); PG8_SCHED; PG8_LDA(At, 1, 0); PG8_STAGE(PG8_SA(0, 1), a2 + hstep, voffA);
            PG8_WAIT_V(8); PG8_WAIT_L(0); PG8_BAR; PG8_MMA(0, 0, At, B0); PG8_MMA(0, 1, At, B1); PG8_BAR; PG8_SCHED;
            PG8_LDA(At, 1, 1); PG8_STAGE(PG8_SB(1, 0), b3, voffB); PG8_STAGE(PG8_SB(1, 1), b3 + hstep, voffB); PG8_STAGE(PG8_SA(1, 0), a3, voffA);
            PG8_WAIT_V(8); PG8_WAIT_L(0); PG8_BAR; PG8_MMA(1, 0, At, B0); PG8_MMA(1, 1, At, B1); PG8_BAR; PG8_SCHED;
            } else {
            PG8_LDB(B0, 0, 0); PG8_SCHED; PG8_LDA(At, 0, 0); PG8_STAGE(PG8_SA(1, 1), a1 + hstep, voffA);
            PG8_WAIT_L(8); PG8_BAR; PG8_WAIT_L(0); PG8_MMA(0, 0, At, B0); PG8_BAR; PG8_SCHED;
            PG8_LDB(B1, 0, 1); PG8_STAGE(PG8_SB(0, 0), b2, voffB);
            PG8_BAR; PG8_WAIT_L(0); PG8_MMA(0, 1, At, B1); PG8_BAR;
            PG8_LDA(At, 0, 1); PG8_STAGE(PG8_SA(0, 0), a2, voffA);
            PG8_BAR; PG8_WAIT_L(0); PG8_MMA(1, 0, At, B0); PG8_BAR; PG8_SCHED;
            PG8_STAGE(PG8_SB(0, 1), b2 + hstep, voffB);
            PG8_WAIT_V(6); PG8_BAR; PG8_MMA(1, 1, At, B1); PG8_BAR;
            PG8_LDB(B0, 1, 0); PG8_SCHED; PG8_LDA(At, 1, 0); PG8_STAGE(PG8_SA(0, 1), a2 + hstep, voffA);
            PG8_WAIT_L(8); PG8_BAR; PG8_WAIT_L(0); PG8_MMA(0, 0, At, B0); PG8_BAR; PG8_SCHED;
            PG8_LDB(B1, 1, 1); PG8_STAGE(PG8_SB(1, 0), b3, voffB);
            PG8_BAR; PG8_WAIT_L(0); PG8_MMA(0, 1, At, B1); PG8_BAR;
            PG8_LDA(At, 1, 1); PG8_STAGE(PG8_SA(1, 0), a3, voffA);
            PG8_BAR; PG8_WAIT_L(0); PG8_MMA(1, 0, At, B0); PG8_BAR; PG8_SCHED;
            PG8_STAGE(PG8_SB(1, 1), b3 + hstep, voffB);
            PG8_WAIT_V(6); PG8_BAR; PG8_MMA(1, 1, At, B1); PG8_BAR;
            }
        }
        if constexpr (ALIGN_EPI) { if (wr == 0) PG8_BAR; }
        if constexpr (!Epi::AFTER_DRAIN) { E(acc, cur, wr, wc, fr, fq); S.done(cur); }
        if (!has_next) break;
#pragma unroll
        for (int a = 0; a < 2; ++a)
#pragma unroll
            for (int b = 0; b < 2; ++b)
#pragma unroll
                for (int m = 0; m < 4; ++m)
#pragma unroll
                    for (int n = 0; n < 2; ++n) acc[a][b][m][n] = (f32x4){0.f, 0.f, 0.f, 0.f};
        cur = nxt; cA = nA; cB = nB; ++ui;
        if constexpr (ALIGN_EPI) { if (wr == 1) PG8_BAR; }
    }
    PG8_WAIT_V(0);
    if constexpr (!ALIGN_EPI) { if (wr == 0) PG8_BAR; }
    PG8_BAR;
    if constexpr (Epi::AFTER_DRAIN) { E.fused(acc, cur, wr, wc, fr, fq, lds, wid, lane); S.done(cur); }
#undef PG8_SA
#undef PG8_SB
#undef PG8_STAGE
#undef PG8_LDA
#undef PG8_LDB
#undef PG8_MMA
#undef PG8_WAIT_V
#undef PG8_WAIT_L
#undef PG8_BAR
#undef PG8_SCHED
}
}
#include <hip/hip_bf16.h>
#include <cmath>
namespace attn_body {
using bf16=__hip_bfloat16;
using bf16x8=__attribute__((ext_vector_type(8)))short;
using s16x4=__attribute__((ext_vector_type(4)))short;
using f32x16=__attribute__((ext_vector_type(16)))float;
using u32x4=__attribute__((ext_vector_type(4)))unsigned;
constexpr int BATCH=32,NHEAD=16,SEQ=2048,D=64,DM=NHEAD*D,OPITCH=2048;
constexpr int NW=8,QBLK=32,QB=QBLK*NW,KVBLK=64,NQB=SEQ/QB;
constexpr int ATTN_PITCH=DM, ATTN_UNIT_ROWS=QB;
__device__ __forceinline__ int crow(int r,int hi){return (r&3)+8*(r>>2)+4*hi;}
#define SBAR() __builtin_amdgcn_sched_barrier(0)
__device__ __forceinline__ void cmask(f32x16&p0,f32x16&p1,int jb,int qrel,int hi){
  const float NEG=-INFINITY; int kb=64*jb+4*hi;
  #pragma unroll
  for(int r=0;r<16;++r){int kv=kb+(r&3)+8*(r>>2); if(kv>qrel)p0[r]=NEG; if(kv+32>qrel)p1[r]=NEG;}
}

constexpr int NSLOT=3, SLOTB=8192;
constexpr int LDS_K=0, LDS_V=NSLOT*SLOTB, LDS_WS=2*NSLOT*SLOTB, LDS_OST=LDS_WS+NW*64*4, LDS_BYTES=LDS_OST+NW*4096;
constexpr float C2=0.125f*1.4426950408889634f;
__device__ __forceinline__ void glds16(const void*gsrc,unsigned lds_dst){unsigned keep;
  asm volatile("s_mov_b32 %0, m0\n\ts_mov_b32 m0, %2\n\ts_nop 0\n\tglobal_load_lds_dwordx4 %1, off\n\ts_mov_b32 m0, %0":"=&s"(keep):"v"(gsrc),"s"(lds_dst):"memory");}
__device__ __forceinline__ float max3f(float a,float b,float c){float r;asm("v_max3_f32 %0, %1, %2, %3":"=v"(r):"v"(a),"v"(b),"v"(c));return r;}
__device__ __forceinline__ float max2f(float a,float b){float r;asm("v_max_f32_e32 %0, %1, %2":"=v"(r):"v"(a),"v"(b));return r;}
__device__ __forceinline__ float fadd_s(float a,float b){float r;asm("v_add_f32_e32 %0, %1, %2":"=v"(r):"v"(a),"v"(b));return r;}
__device__ __forceinline__ float fsub_s(float a,float b){float r;asm("v_sub_f32_e32 %0, %1, %2":"=v"(r):"v"(a),"v"(b));return r;}
typedef float f32x2_t __attribute__((ext_vector_type(2))); typedef __bf16 bf16x2_t __attribute__((ext_vector_type(2)));
__device__ __forceinline__ unsigned cvtpk_s(float lo,float hi){f32x2_t v={lo,hi};bf16x2_t b=__builtin_convertvector(v,bf16x2_t);return __builtin_bit_cast(unsigned,b);}
#define WAIT_BAR(N) asm volatile("s_waitcnt vmcnt(" #N ") lgkmcnt(0)\n\ts_barrier":::"memory")

__device__ __forceinline__ void qkt(f32x16&p0,f32x16&p1,const char*Kslot,const bf16x8*qr,const f32x16&negm,int r32,int hi){
  const char*kb=Kslot+hi*1024+r32*16;
  #pragma unroll
  for(int d0=0;d0<4;++d0){
    const bf16x8 b0=*reinterpret_cast<const bf16x8*>(kb+d0*2048);
    const bf16x8 b1=*reinterpret_cast<const bf16x8*>(kb+d0*2048+512);
    if(d0==0){p0=__builtin_amdgcn_mfma_f32_32x32x16_bf16(b0,qr[0],negm,0,0,0);p1=__builtin_amdgcn_mfma_f32_32x32x16_bf16(b1,qr[0],negm,0,0,0);}
    else{p0=__builtin_amdgcn_mfma_f32_32x32x16_bf16(b0,qr[d0],p0,0,0,0);p1=__builtin_amdgcn_mfma_f32_32x32x16_bf16(b1,qr[d0],p1,0,0,0);}}
}
typedef __attribute__((address_space(3))) const char* lds_cptr;
typedef short v4i16_t __attribute__((ext_vector_type(4)));
__device__ __forceinline__ void kload8(bf16x8*kf,lds_cptr kp){
  kf[0]=*(const __attribute__((address_space(3))) bf16x8*)(kp);      kf[1]=*(const __attribute__((address_space(3))) bf16x8*)(kp+512);
  kf[2]=*(const __attribute__((address_space(3))) bf16x8*)(kp+2048); kf[3]=*(const __attribute__((address_space(3))) bf16x8*)(kp+2560);
  kf[4]=*(const __attribute__((address_space(3))) bf16x8*)(kp+4096); kf[5]=*(const __attribute__((address_space(3))) bf16x8*)(kp+4608);
  kf[6]=*(const __attribute__((address_space(3))) bf16x8*)(kp+6144); kf[7]=*(const __attribute__((address_space(3))) bf16x8*)(kp+6656);
}
__device__ __forceinline__ void kload2(bf16x8*kf,lds_cptr kp,int j){ kf[2*j]=*(const __attribute__((address_space(3))) bf16x8*)(kp+j*2048); kf[2*j+1]=*(const __attribute__((address_space(3))) bf16x8*)(kp+j*2048+512); }
__device__ __forceinline__ s16x4 vtr(lds_cptr p){ return __builtin_bit_cast(s16x4,__builtin_amdgcn_ds_read_tr16_b64_v4i16((__attribute__((address_space(3))) v4i16_t*)p)); }
__device__ __forceinline__ float rowmax(const f32x16&p0,const f32x16&p1){
  float a=max3f(p0[0],p0[1],p1[0]),b=max3f(p0[2],p0[3],p1[1]);a=max3f(a,p1[2],p1[3]);
  #pragma unroll
  for(int r=4;r<16;r+=4){a=max3f(a,p0[r],p0[r+1]);b=max3f(b,p0[r+2],p0[r+3]);a=max3f(a,p1[r],p1[r+1]);b=max3f(b,p1[r+2],p1[r+3]);}
  const float m=max2f(a,b);
  auto rr=__builtin_amdgcn_permlane32_swap(__float_as_uint(m),__float_as_uint(m),false,false);
  return max2f(__uint_as_float(rr[0]),__uint_as_float(rr[1]));
}
__device__ __forceinline__ void pv(f32x16*o,int vb,bf16x8 pa0,bf16x8 pa1,bf16x8 pa2,bf16x8 pa3){
  #pragma unroll
  for(int d0=0;d0<2;++d0){s16x4 lo[4],hi[4];
    #pragma unroll
    for(int ks=0;ks<4;++ks){
      asm volatile("ds_read_b64_tr_b16 %0,%1 offset:%c2":"=&v"(lo[ks]):"v"(vb),"i"(d0*4096+ks*1024):"memory");
      asm volatile("ds_read_b64_tr_b16 %0,%1 offset:%c2":"=&v"(hi[ks]):"v"(vb),"i"(d0*4096+ks*1024+512):"memory");}
    asm volatile("s_waitcnt lgkmcnt(0)":::"memory");SBAR();
    #define PK(k) (bf16x8){lo[k][0],lo[k][1],lo[k][2],lo[k][3],hi[k][0],hi[k][1],hi[k][2],hi[k][3]}
    o[d0]=__builtin_amdgcn_mfma_f32_32x32x16_bf16(pa0,PK(0),o[d0],0,0,0);
    o[d0]=__builtin_amdgcn_mfma_f32_32x32x16_bf16(pa1,PK(1),o[d0],0,0,0);
    o[d0]=__builtin_amdgcn_mfma_f32_32x32x16_bf16(pa2,PK(2),o[d0],0,0,0);
    o[d0]=__builtin_amdgcn_mfma_f32_32x32x16_bf16(pa3,PK(3),o[d0],0,0,0);
    #undef PK
  }
}

#ifndef ATTN_STORE16
#define ATTN_STORE16(p,v) (*(u32x4*)(p)=(v))
#endif
template<int THRL> __device__ __forceinline__ void attn_unit(int b,int h,int vcol,int ocol,int qb,const bf16*Q,const bf16*__restrict__ K,const bf16*__restrict__ V,bf16*O,char*shm,const int tid_in){
  int tid=tid_in; asm volatile("":"+v"(tid)); tid&=511;
  const int lane=tid&63,r32=lane&31,hi=lane>>5; const int wid=__builtin_amdgcn_readfirstlane(tid>>6);
  const long rowbase=(long)b*SEQ; const int q0=qb*QB;
  const bf16*Qw=Q+(rowbase+q0+wid*QBLK)*DM+h*D;
  const bf16*Kh=K+rowbase*DM+h*D,*Vh=V+rowbase*DM+vcol;
  const unsigned lds0=(unsigned)(uintptr_t)shm;
  float*wsf=(float*)(shm+LDS_WS)+wid*64;
  const bf16*ksrc=Kh+(long)lane*DM+wid*8;
  const bf16*vsrc=Vh+(long)(16*(wid&3)+(lane>>2))*DM+(wid>>2)*32+(lane&3)*8;
  const unsigned kdst=lds0+LDS_K+wid*1024, vdst=lds0+LDS_V+wid*1024;
  #define DMA_K(t,slot) glds16(ksrc+(long)(t)*KVBLK*DM,(unsigned)__builtin_amdgcn_readfirstlane(kdst+(slot)))
  #define DMA_V(t,slot) glds16(vsrc+(long)(t)*KVBLK*DM,(unsigned)__builtin_amdgcn_readfirstlane(vdst+(slot)))
  const int vb0=(int)(lds0+LDS_V)+((lane>>4)&1)*32+(lane&3)*8+(4*hi+((lane&15)>>2))*64;
  const char*Kbase=shm+LDS_K; bf16x8 kf[8];
  const lds_cptr shm3=(lds_cptr)shm; const lds_cptr kp0=shm3+LDS_K+hi*1024+r32*16; const lds_cptr vp0=shm3+LDS_V+((lane>>4)&1)*32+(lane&3)*8+(4*hi+((lane&15)>>2))*64;
  const int NT=(q0+QB)/KVBLK;
  DMA_K(0,0);DMA_V(0,0);DMA_K(1,SLOTB);
  bf16x8 qr[4];
  #pragma unroll
  for(int d0=0;d0<4;++d0)qr[d0]=*reinterpret_cast<const bf16x8*>(&Qw[(long)r32*DM+d0*16+hi*8]);
  float mhat=0.f,l_reg=0.f;f32x16 o[2];f32x16 negm; { float zz; asm volatile("v_mov_b32 %0, 0":"=v"(zz));
    _Pragma("unroll") for(int r=0;r<16;++r){o[0][r]=zz;o[1][r]=zz;negm[r]=zz;} } asm volatile("":"+v"(negm));
  const int qrel=wid*QBLK+r32;
  #define CMASK(P0,P1,t) do{int jb_=(t)-(NT-4); if(jb_>=0)cmask(P0,P1,jb_,qrel,hi);}while(0)
  bool resc=false;
  #define START(P0,P1) do{ const float rm=rowmax(P0,P1); resc=false; \
    { const float dl=rm; mhat=fadd_s(mhat,dl); \
      _Pragma("unroll") for(int r=0;r<16;++r){P0[r]=fsub_s(P0[r],dl);P1[r]=fsub_s(P1[r],dl);} \
      _Pragma("unroll") for(int r=0;r<16;++r)negm[r]=-mhat; asm volatile("":"+v"(negm)); } \
    _Pragma("unroll") for(int r=0;r<16;++r)P0[r]=__builtin_amdgcn_exp2f(P0[r]); }while(0)
  #define RESC() do{ if(resc){ asm volatile("s_waitcnt lgkmcnt(0)":::"memory"); \
      _Pragma("unroll") for(int d_=0;d_<2;++d_) _Pragma("unroll") for(int r=0;r<16;++r)o[d_][r]*=wsf[crow(r,hi)]; } }while(0)
  f32x16 pA0,pA1,pB0,pB1;
  int sl_prev=0,sl_cur=0,sl_next=SLOTB;
  #define ROT() do{sl_prev=sl_cur;sl_cur=sl_next;sl_next=(sl_next==(NSLOT-1)*SLOTB)?0:sl_next+SLOTB;}while(0)
  DMA_K(2,2*SLOTB);
  WAIT_BAR(3);
  qkt(pA0,pA1,Kbase,qr,negm,r32,hi);asm volatile("s_nop 15\n\ts_nop 7":"+v"(pA0),"+v"(pA1));CMASK(pA0,pA1,0);
  START(pA0,pA1);
  _Pragma("unroll") for(int r=0;r<16;++r)pA1[r]=__builtin_amdgcn_exp2f(pA1[r]);
  WAIT_BAR(0);
  DMA_K(3,0);DMA_V(1,SLOTB);
  ROT();
  kload8(kf,kp0+sl_cur);
  WAIT_BAR(2);
  s16x4 vlo[8],vhi[8]; u32x4 pw0,pw1,pw2,pw3;
  #define PKW(P,B) cvtpk_s(P[B],P[B+1])
  #define PAF(k) __builtin_bit_cast(bf16x8,pw##k)
  #define VFR(i) (bf16x8){vlo[i][0],vlo[i][1],vlo[i][2],vlo[i][3],vhi[i][0],vhi[i][1],vhi[i][2],vhi[i][3]}
  #define PIN(x) asm volatile("":"+v"(x))
  #define MX3(a,b,c) __builtin_fmaxf(__builtin_fmaxf((a),(b)),(c))
  #define GAPA(MF,A0,A1,A2,A3,W0,W1,PW) do{ MF; sacc+=A0; sacc+=A1; sacc+=A2; sacc+=A3; PIN(sacc); W0; W1; PIN(PW); SBAR(); }while(0)
  #define EX(v) __builtin_amdgcn_exp2f(v)
  #define GAPB(MF,X,B) do{ MF; X[B]=EX(X[B]); X[B+1]=EX(X[B+1]); X[B+2]=EX(X[B+2]); X[B+3]=EX(X[B+3]); PIN(X); SBAR(); }while(0)
  #define VRD(i) do{ vlo[i]=vtr(vp_+(((i)>>2)*4096+((i)&3)*1024)); vhi[i]=vtr(vp_+(((i)>>2)*4096+((i)&3)*1024+512)); }while(0)
  #define KRD(G,j) do{ if(G){ kload2(kf,kp0+sl_next,j); SBAR(); } }while(0)
  #define STEP(C0,C1,P0,P1,t,GK,GV,GL) do{ SBAR(); \
    const lds_cptr vp_=vp0+sl_prev; \
    VRD(0); SBAR(); float sacc=(P0[0]+P0[1]); \
    GAPA(C0=__builtin_amdgcn_mfma_f32_32x32x16_bf16(kf[0],qr[0],negm,0,0,0), P0[2],P0[3],P0[4],P0[5],     pw0[0]=PKW(P0,0), pw0[1]=PKW(P0,2), pw0); \
    VRD(4); SBAR(); GAPA(C1=__builtin_amdgcn_mfma_f32_32x32x16_bf16(kf[1],qr[0],negm,0,0,0), P0[6],P0[7],P0[8],P0[9],     pw0[2]=PKW(P0,4), pw0[3]=PKW(P0,6), pw0); \
    VRD(1); SBAR(); GAPA(C0=__builtin_amdgcn_mfma_f32_32x32x16_bf16(kf[2],qr[1],C0,0,0,0),   P0[10],P0[11],P0[12],P0[13], pw1[0]=PKW(P0,8), pw1[1]=PKW(P0,10), pw1); \
    VRD(5); SBAR(); GAPA(C1=__builtin_amdgcn_mfma_f32_32x32x16_bf16(kf[3],qr[1],C1,0,0,0),   P0[14],P0[15],P1[0],P1[1],   pw1[2]=PKW(P0,12),pw1[3]=PKW(P0,14), pw1); \
    VRD(2); SBAR(); GAPA(C0=__builtin_amdgcn_mfma_f32_32x32x16_bf16(kf[4],qr[2],C0,0,0,0),   P1[2],P1[3],P1[4],P1[5],     pw2[0]=PKW(P1,0), pw2[1]=PKW(P1,2), pw2); \
    VRD(6); SBAR(); GAPA(C1=__builtin_amdgcn_mfma_f32_32x32x16_bf16(kf[5],qr[2],C1,0,0,0),   P1[6],P1[7],P1[8],P1[9],     pw2[2]=PKW(P1,4), pw2[3]=PKW(P1,6), pw2); \
    VRD(3); SBAR(); GAPA(C0=__builtin_amdgcn_mfma_f32_32x32x16_bf16(kf[6],qr[3],C0,0,0,0),   P1[10],P1[11],P1[12],P1[13], pw3[0]=PKW(P1,8), pw3[1]=PKW(P1,10), pw3); \
    VRD(7); SBAR(); GAPA(C1=__builtin_amdgcn_mfma_f32_32x32x16_bf16(kf[7],qr[3],C1,0,0,0),   P1[14],P1[15],0.f,0.f,       pw3[2]=PKW(P1,12),pw3[3]=PKW(P1,14), pw3); \
    l_reg+=sacc; \
    if(GK){DMA_K((t)+3,sl_cur);} if(GV){DMA_V((t)+1,sl_next);} \
    CMASK(C0,C1,t); \
    { float a=MX3(C0[0],C0[1],C1[0]),b=MX3(C0[2],C0[3],C1[1]); a=MX3(a,C1[2],C1[3]); \
      _Pragma("unroll") for(int r=4;r<16;r+=4){a=MX3(a,C0[r],C0[r+1]);b=MX3(b,C0[r+2],C0[r+3]);a=MX3(a,C1[r],C1[r+1]);b=MX3(b,C1[r+2],C1[r+3]);} \
      float rm=__builtin_fmaxf(a,b); { auto rr=__builtin_amdgcn_permlane32_swap(__float_as_uint(rm),__float_as_uint(rm),false,false); rm=__builtin_fmaxf(__uint_as_float(rr[0]),__uint_as_float(rr[1])); } \
      resc=false; \
      if(__builtin_expect(__any(rm>(float)THRL),0)){ const float dl=__builtin_fmaxf(rm,0.f); mhat+=dl; \
        _Pragma("unroll") for(int r=0;r<16;++r){C0[r]-=dl;C1[r]-=dl;} \
        _Pragma("unroll") for(int r=0;r<16;++r)negm[r]=-mhat; asm volatile("":"+v"(negm)); \
        const float f=__builtin_amdgcn_exp2f(-dl); l_reg*=f; if(hi==0)wsf[r32]=f; resc=true; } } \
    SBAR(); \
    GAPB(o[0]=__builtin_amdgcn_mfma_f32_32x32x16_bf16(PAF(0),VFR(0),o[0],0,0,0), C0,0); \
    GAPB(o[1]=__builtin_amdgcn_mfma_f32_32x32x16_bf16(PAF(0),VFR(4),o[1],0,0,0), C0,4); \
    KRD(GL,0); GAPB(o[0]=__builtin_amdgcn_mfma_f32_32x32x16_bf16(PAF(1),VFR(1),o[0],0,0,0), C0,8); \
    KRD(GL,1); GAPB(o[1]=__builtin_amdgcn_mfma_f32_32x32x16_bf16(PAF(1),VFR(5),o[1],0,0,0), C0,12); \
    KRD(GL,2); GAPB(o[0]=__builtin_amdgcn_mfma_f32_32x32x16_bf16(PAF(2),VFR(2),o[0],0,0,0), C1,0); \
    KRD(GL,3); GAPB(o[1]=__builtin_amdgcn_mfma_f32_32x32x16_bf16(PAF(2),VFR(6),o[1],0,0,0), C1,4); \
    GAPB(o[0]=__builtin_amdgcn_mfma_f32_32x32x16_bf16(PAF(3),VFR(3),o[0],0,0,0), C1,8); \
    GAPB(o[1]=__builtin_amdgcn_mfma_f32_32x32x16_bf16(PAF(3),VFR(7),o[1],0,0,0), C1,12); \
    }while(0)
  int t=1;
  #undef CMASK
  #define CMASK(P0,P1,t) do{}while(0)
  for(;t+5<NT;t+=2){
    STEP(pB0,pB1,pA0,pA1,t,true,true,true);     WAIT_BAR(2); RESC(); ROT();
    STEP(pA0,pA1,pB0,pB1,t+1,true,true,true);   WAIT_BAR(2); RESC(); ROT();
  }
  #undef CMASK
  #define CMASK(P0,P1,t) do{int jb_=(t)-(NT-4); if(jb_>=0)cmask(P0,P1,jb_,qrel,hi);}while(0)
  #define ENDW(tt) do{ if((tt)+3<NT){WAIT_BAR(2);} else if((tt)+2<NT){WAIT_BAR(1);} else {WAIT_BAR(0);} }while(0)
  for(;t+1<NT;t+=2){
    STEP(pB0,pB1,pA0,pA1,t,(t+3<NT),(t+1<NT),(t+1<NT));       ENDW(t);   RESC(); ROT();
    STEP(pA0,pA1,pB0,pB1,t+1,(t+4<NT),(t+2<NT),(t+2<NT));     ENDW(t+1); RESC(); ROT();
  }
  STEP(pB0,pB1,pA0,pA1,NT-1,false,false,false); RESC();
  { float sacc=pB0[0]+pB0[1]; _Pragma("unroll") for(int r=2;r<16;++r)sacc+=pB0[r]; _Pragma("unroll") for(int r=0;r<16;++r)sacc+=pB1[r]; l_reg+=sacc;
    pw0=(u32x4){PKW(pB0,0),PKW(pB0,2),PKW(pB0,4),PKW(pB0,6)};pw1=(u32x4){PKW(pB0,8),PKW(pB0,10),PKW(pB0,12),PKW(pB0,14)};pw2=(u32x4){PKW(pB1,0),PKW(pB1,2),PKW(pB1,4),PKW(pB1,6)};pw3=(u32x4){PKW(pB1,8),PKW(pB1,10),PKW(pB1,12),PKW(pB1,14)};
    SBAR(); pv(o,vb0+sl_cur,PAF(0),PAF(1),PAF(2),PAF(3)); }
  #undef PKW
  #undef PAF
  #undef VFR
  #undef PIN
  #undef MX3
  #undef GAPA
  #undef GAPB
  #undef EX
  #undef VRD
  #undef KRD
  #undef STEP
  #undef ENDW
  {auto rr=__builtin_amdgcn_permlane32_swap(__float_as_uint(l_reg),__float_as_uint(l_reg),false,false);l_reg=__uint_as_float(rr[0])+__uint_as_float(rr[1]);}
  if(hi==0)wsf[32+r32]=l_reg;asm volatile("s_waitcnt lgkmcnt(0)":::"memory");
  float rli[16];
  #pragma unroll
  for(int r=0;r<16;++r)rli[r]=__builtin_amdgcn_rcpf(wsf[32+crow(r,hi)]);
  bf16*Ow=O+(rowbase+q0+wid*QBLK)*OPITCH+ocol;
  { bf16*stg=(bf16*)(shm+LDS_OST)+wid*2048;
    #pragma unroll
    for(int r=0;r<16;++r){const int orow=crow(r,hi);
      #pragma unroll
      for(int d0=0;d0<2;++d0)stg[orow*64+d0*32+r32]=__float2bfloat16(o[d0][r]*rli[r]);}
    asm volatile("s_waitcnt lgkmcnt(0)":::"memory");
    #pragma unroll
    for(int i=0;i<4;++i){const int row=i*8+(lane>>3),ch=lane&7; const u32x4 v=*(const u32x4*)(stg+row*64+ch*8); ATTN_STORE16(Ow+(long)row*OPITCH+ch*8,v);} }
  asm volatile("s_waitcnt lgkmcnt(0)\n\ts_barrier":::"memory");
  #undef DMA_K
  #undef DMA_V
  #undef CMASK
  #undef START
  #undef RESC
  #undef ROT
}
constexpr int ATTN_LDS_BYTES=LDS_BYTES;
#undef SBAR
#undef WAIT_BAR
}
namespace cg = cooperative_groups;
constexpr int NWAVES = 8;
constexpr int BATCH = 32, SEQ = 2048, D = 1024, M = BATCH * SEQ, DFF = 2816, GW = 1536;
constexpr size_t MiB = 1u << 20;
constexpr size_t WS_W_ATT_IN = 1 * MiB, WS_W_ATT_OUT = 13 * MiB, WS_W_G_IN = 17 * MiB, WS_W_G_OUT = 23 * MiB, WS_W_C_IN = 26 * MiB, WS_W_C_OUT = 32 * MiB, WS_W_GU = 34 * MiB, WS_W_DN = 78 * MiB, WS_WSB = 100 * MiB;
constexpr size_t WS_ROPE = 101 * MiB, WS_SSQ = 117 * MiB, WS_VSTAT = 121 * MiB, WS_XB = 133 * MiB, WS_ARENA = 261 * MiB, WS_END = 901 * MiB;
constexpr size_t AR_Q = 0, AR_K = 128 * MiB, AR_V = 256 * MiB, AR_O = 384 * MiB;
constexpr size_t AR_U = 0, AR_GV = 192 * MiB, AR_UV = 384 * MiB;
constexpr size_t AR_GB = 0, AR_HC = 128 * MiB, AR_Y = 256 * MiB;
constexpr size_t AR_H = 0;
constexpr int LDS_BYTES = 147456;

#define GAS __attribute__((address_space(1)))
#define LAS __attribute__((address_space(3)))
typedef unsigned short bf16;
typedef unsigned v4u __attribute__((ext_vector_type(4)));
typedef unsigned v2u __attribute__((ext_vector_type(2)));
typedef float f32x4 __attribute__((ext_vector_type(4)));
typedef float f32x2 __attribute__((ext_vector_type(2)));
typedef short bf16x8 __attribute__((ext_vector_type(8)));
typedef short s16x4 __attribute__((ext_vector_type(4)));
#define LDS_WAIT() asm volatile("s_waitcnt lgkmcnt(0)" ::: "memory")
#define VM_WAIT() asm volatile("s_waitcnt vmcnt(0)" ::: "memory")
__device__ __forceinline__ unsigned f2bf(float f) { unsigned u = __builtin_bit_cast(unsigned, f); return (u + 0x7fffu + ((u >> 16) & 1u)) >> 16; }
__device__ __forceinline__ unsigned pk2(float lo, float hi) { return f2bf(lo) | (f2bf(hi) << 16); }
__device__ __forceinline__ float bflo(unsigned w) { return __uint_as_float(w << 16); }
__device__ __forceinline__ float bfhi(unsigned w) { return __uint_as_float(w & 0xffff0000u); }
__device__ __forceinline__ float wave_sum(float v) {
#pragma unroll
    for (int o = 1; o < 64; o <<= 1) v += __shfl_xor(v, o);
    return v;
}

struct Params { const void* in[21]; float* out; unsigned char* ws; float lam0, lam1; };

__device__ __forceinline__ void p0_item(const float* W, int K, int N, bf16* WT, const float* gain, int kind, LAS float* scr, int item, int lane) {
    const int nblk = N / 32, kb = item / nblk, nb = item % nblk, k0 = 64 * kb, n0 = 32 * nb;
    int d0 = n0;
    if (kind == 1) { if (n0 < 2048) { const int part = n0 >> 10, head = (n0 >> 6) & 15, half = (n0 >> 5) & 1; d0 = (part * 4 + (head >> 2)) * 256 + half * 128 + (head & 3) * 32; } }
    else if (kind == 2) { if (n0 < 2816) d0 = (n0 >> 7) * 256 + (n0 & 127); else { const int j = n0 - 2816; d0 = (j >> 7) * 256 + 128 + (j & 127); } }
    else if (kind == 3) { if (n0 >= 2048) { const int j = n0 - 2048; d0 = 1024 + (j >> 7) * 256 + 128 + (j & 127); } else if (n0 >= 1024) { const int j = n0 - 1024; d0 = 1024 + (j >> 7) * 256 + (j & 127); } }
#pragma unroll 8
    for (int i = 0; i < 32; ++i) { const int kk = 2 * i + (lane >> 5); float v = W[(size_t)(k0 + kk) * N + n0 + (lane & 31)]; if (gain) v *= gain[k0 + kk]; scr[kk * 33 + (lane & 31)] = v; }
    LDS_WAIT(); asm volatile("" ::: "memory");
    const int c = lane & 7;
#pragma unroll
    for (int j = 0; j < 4; ++j) { const int n = (lane >> 3) + 8 * j; const LAS float* s = scr + (8 * c) * 33 + n;
        v4u o; o.x = pk2(s[0 * 33], s[1 * 33]); o.y = pk2(s[2 * 33], s[3 * 33]); o.z = pk2(s[4 * 33], s[5 * 33]); o.w = pk2(s[6 * 33], s[7 * 33]);
        *(v4u*)(WT + (size_t)(d0 + n) * K + k0 + 8 * c) = o; }
    LDS_WAIT(); asm volatile("" ::: "memory");
}

typedef const __attribute__((address_space(4))) unsigned char* kaptr_t;
#define KIN(k) ((const float*)(*(const unsigned long long __attribute__((address_space(4)))*)(ka + 8 * (k))))
#define KOUT ((float*)(*(const unsigned long long __attribute__((address_space(4)))*)(ka + 168)))
#define KWS ((unsigned char*)(*(const unsigned long long __attribute__((address_space(4)))*)(ka + 176)))
#define KLAM(jj) (*(const float __attribute__((address_space(4)))*)(ka + 184 + 4 * (jj)))
#define LAUNDER() do { asm volatile("" : "+s"(ka)); asm volatile("" : "+v"(tid)); tid &= 511; } while (0)
#define WSPTRS() unsigned char* const ws = KWS; bf16* const XB = (bf16*)(ws + WS_XB); float* const SSQ = (float*)(ws + WS_SSQ); unsigned char* const AR = ws + WS_ARENA; (void)XB; (void)SSQ; (void)AR

__device__ __forceinline__ void light_step(const int step, kaptr_t& ka, int& tid, LAS unsigned char* const L, const int G, const int bx, const int vcu) {
        const int layer = step / 5, stage = step % 5, kind = layer % 3, j = layer / 3;
        LAUNDER(); WSPTRS();
        const int lane = tid & 63, wave = __builtin_amdgcn_readfirstlane(tid >> 6); (void)lane; (void)wave;
        if (stage != 1) {
            pg8::Gemm g; pg8::EpiGen E;
            float* const out = KOUT;
            g.M = M; E.ssq = SSQ; E.eps = 1e-6f; E.o0 = nullptr; E.o1 = nullptr; E.o2 = nullptr; E.rope = (const pg8::f32x4*)(ws + WS_ROPE); E.bias = KIN(10); E.vstat = (pg8::f32x2e*)(ws + WS_VSTAT); E.xin = out; E.xout = out;
            if (stage == 0) {
                g.A = XB; g.K = 1024; g.N = 3072;
                if (kind == 0) { g.Bt = (const bf16*)(ws + WS_W_ATT_IN) + (size_t)j * 3145728; E.mode = 0; E.o0 = (bf16*)(AR + AR_Q); E.o1 = (bf16*)(AR + AR_K); E.o2 = (bf16*)(AR + AR_V); }
                else if (kind == 1) { g.Bt = (const bf16*)(ws + WS_W_G_IN); E.mode = 1; E.o0 = (bf16*)(AR + AR_U); E.o1 = (bf16*)(AR + AR_GV); }
                else { g.Bt = (const bf16*)(ws + WS_W_C_IN); E.mode = 2; E.o0 = (bf16*)(AR + AR_GB); E.o1 = (bf16*)(AR + AR_HC); }
            } else if (stage == 2) {
                g.N = 1024; E.mode = 3; E.o0 = XB; if (layer == 0) E.xin = KIN(0);
                if (kind == 0) { g.A = (const bf16*)(AR + AR_Q); g.Bt = (const bf16*)(ws + WS_W_ATT_OUT) + (size_t)j * 1048576; g.K = 1024; }
                else if (kind == 1) { g.A = (const bf16*)(AR + AR_UV); g.Bt = (const bf16*)(ws + WS_W_G_OUT); g.K = 1536; }
                else { g.A = (const bf16*)(AR + AR_Y); g.Bt = (const bf16*)(ws + WS_W_C_OUT); g.K = 1024; }
            } else if (stage == 3) {
                g.A = XB; g.Bt = (const bf16*)(ws + WS_W_GU) + (size_t)layer * 5767168; g.N = 5632; g.K = 1024; E.mode = 4; E.o0 = (bf16*)(AR + AR_H);
            } else {
                g.A = (const bf16*)(AR + AR_H); g.Bt = (const bf16*)(ws + WS_W_DN) + (size_t)layer * 2883584; g.N = 1024; g.K = 2816; E.mode = 3; E.o0 = (layer == 3) ? nullptr : XB;
            }
            pg8::StaticOrder S; S.init(g.M, g.N, G, bx);
            pg8::gemm_phase<pg8::EpiGen, pg8::StaticOrder, true, true>(L, g, S, E, tid);
        } else if (kind == 1) {
            const bf16* U = (const bf16*)(AR + AR_U); const bf16* GV = (const bf16*)(AR + AR_GV); bf16* UV = (bf16*)(AR + AR_UV);
            LAS f32x2* stat = (LAS f32x2*)(L + 51200); const f32x2* VSTAT = (const f32x2*)(ws + WS_VSTAT); const bf16* WSB = (const bf16*)(ws + WS_WSB);
            const float* gmlp_ln_g = KIN(11); const float* gmlp_ln_b = KIN(12); const float* gmlp_b_s = KIN(14);
            const int fr = lane & 15, fq = lane >> 4;
            for (int unit = vcu; unit < 4096; unit += G) {
                const int chunk = unit >> 3, gg = unit & 7; const size_t row0 = (size_t)chunk * 128;
                __syncthreads();
                if (tid < 128) {
                    const f32x4* ps = (const f32x4*)(VSTAT + (row0 + tid) * 24); float s1 = 0.f, s2 = 0.f;
#pragma unroll
                    for (int i = 0; i < 12; ++i) { const f32x4 q = ps[i]; s1 += q[0] + q[2]; s2 += q[1] + q[3]; }
                    const float mean = s1 * (1.0f / 1536.0f); const float var = fmaxf(s2 * (1.0f / 1536.0f) - mean * mean, 0.f);
                    stat[tid] = (f32x2){mean, __builtin_amdgcn_rsqf(var + 1e-5f)};
                }
                __syncthreads();
#pragma unroll
                for (int i = 0; i < 6; ++i) {
                    const int w = tid + 512 * i, r = w / 24, cgp = w % 24; const int c = gg * 192 + cgp * 8;
                    const v4u raw = *(const v4u*)(GV + (row0 + r) * 1536 + c);
                    const f32x2 st = stat[r];
                    const f32x4 ga = *(const f32x4*)(gmlp_ln_g + c), gb = *(const f32x4*)(gmlp_ln_g + c + 4), ba = *(const f32x4*)(gmlp_ln_b + c), bb = *(const f32x4*)(gmlp_ln_b + c + 4);
                    f32x4 v0 = (f32x4){bflo(raw.x), bfhi(raw.x), bflo(raw.y), bfhi(raw.y)}, v1 = (f32x4){bflo(raw.z), bfhi(raw.z), bflo(raw.w), bfhi(raw.w)};
                    v0 = (v0 - st.x) * st.y * ga + ba; v1 = (v1 - st.x) * st.y * gb + bb;
                    *(LAS v4u*)(L + r * 400 + cgp * 16) = (v4u){pk2(v0[0], v0[1]), pk2(v0[2], v0[3]), pk2(v1[0], v1[1]), pk2(v1[2], v1[3])};
                }
                __syncthreads();
                f32x4 acc[12];
#pragma unroll
                for (int n = 0; n < 12; ++n) acc[n] = (f32x4){0.f, 0.f, 0.f, 0.f};
                const int nk = (wave >> 1) + 1;
                for (int kk = 0; kk < nk; ++kk) {
                    const bf16x8 wsf = *(const bf16x8*)(WSB + ((size_t)gg * 128 + 16 * wave + fr) * 128 + 32 * kk + 8 * fq);
                    const LAS unsigned char* tb = L + (32 * kk + 8 * fq + ((lane >> 2) & 3)) * 400 + (lane & 3) * 8;
#pragma unroll
                    for (int n = 0; n < 12; ++n) {
                        const s16x4 lo = __builtin_bit_cast(s16x4, __builtin_amdgcn_ds_read_tr16_b64_v4i16((LAS s16x4*)(tb + n * 32)));
                        const s16x4 hi = __builtin_bit_cast(s16x4, __builtin_amdgcn_ds_read_tr16_b64_v4i16((LAS s16x4*)(tb + n * 32 + 1600)));
                        const bf16x8 vf = (bf16x8){lo[0], lo[1], lo[2], lo[3], hi[0], hi[1], hi[2], hi[3]};
                        acc[n] = __builtin_amdgcn_mfma_f32_16x16x32_bf16(vf, wsf, acc[n], 0, 0, 0);
                    }
                }
                const int t = 16 * wave + fr; const float bs = gmlp_b_s[gg * 128 + t];
#pragma unroll
                for (int n = 0; n < 12; ++n) {
                    const size_t o = (row0 + t) * 1536 + gg * 192 + 16 * n + 4 * fq;
                    const v2u uu = *(const v2u*)(U + o);
                    const f32x4 sv = acc[n] + bs;
                    *(v2u*)(UV + o) = (v2u){pk2(bflo(uu.x) * sv[0], bfhi(uu.x) * sv[1]), pk2(bflo(uu.y) * sv[2], bfhi(uu.y) * sv[3])};
                }
            }
        } else {
            const float* conv_w = KIN(17);
            const bf16* GBp = (const bf16*)(AR + AR_GB); const bf16* HC = (const bf16*)(AR + AR_HC); bf16* Y = (bf16*)(AR + AR_Y);
            const int gt = vcu * (NWAVES * 64) + tid, NGT = G * NWAVES * 64;
            for (int it = gt; it < (M / 8) * 128; it += NGT) {
                const int cgp = it & 127, rb = it >> 7, c = cgp * 8; const size_t t0 = (size_t)rb * 8;
                const f32x4 w0a = *(const f32x4*)(conv_w + c), w0b = *(const f32x4*)(conv_w + c + 4), w1a = *(const f32x4*)(conv_w + 1024 + c), w1b = *(const f32x4*)(conv_w + 1024 + c + 4), w2a = *(const f32x4*)(conv_w + 2048 + c), w2b = *(const f32x4*)(conv_w + 2048 + c + 4);
                f32x4 m2a = (f32x4){0.f, 0.f, 0.f, 0.f}, m2b = m2a, m1a = m2a, m1b = m2a;
                if ((t0 & (SEQ - 1)) != 0) {
                    const v4u r2 = *(const v4u*)(HC + (t0 - 2) * 1024 + c), r1 = *(const v4u*)(HC + (t0 - 1) * 1024 + c);
                    m2a = (f32x4){bflo(r2.x), bfhi(r2.x), bflo(r2.y), bfhi(r2.y)}; m2b = (f32x4){bflo(r2.z), bfhi(r2.z), bflo(r2.w), bfhi(r2.w)};
                    m1a = (f32x4){bflo(r1.x), bfhi(r1.x), bflo(r1.y), bfhi(r1.y)}; m1b = (f32x4){bflo(r1.z), bfhi(r1.z), bflo(r1.w), bfhi(r1.w)};
                }
#pragma unroll
                for (int r = 0; r < 8; ++r) {
                    const v4u hr = *(const v4u*)(HC + (t0 + r) * 1024 + c), gr = *(const v4u*)(GBp + (t0 + r) * 1024 + c);
                    const f32x4 ha = (f32x4){bflo(hr.x), bfhi(hr.x), bflo(hr.y), bfhi(hr.y)}, hb = (f32x4){bflo(hr.z), bfhi(hr.z), bflo(hr.w), bfhi(hr.w)};
                    const f32x4 ga = (f32x4){bflo(gr.x), bfhi(gr.x), bflo(gr.y), bfhi(gr.y)}, gb = (f32x4){bflo(gr.z), bfhi(gr.z), bflo(gr.w), bfhi(gr.w)};
                    const f32x4 ya = ga * (w0a * m2a + w1a * m1a + w2a * ha), yb = gb * (w0b * m2b + w1b * m1b + w2b * hb);
                    *(v4u*)(Y + (t0 + r) * 1024 + c) = (v4u){pk2(ya[0], ya[1]), pk2(ya[2], ya[3]), pk2(yb[0], yb[1]), pk2(yb[2], yb[3])};
                    m2a = m1a; m2b = m1b; m1a = ha; m1b = hb;
                }
            }
        }
}

__device__ __forceinline__ void attn_step(const int j, kaptr_t& ka, int& tid, char* const ldsg, const int G, const int vcu) {
        LAUNDER(); WSPTRS();
        {
            const attn_body::bf16* Q = (const attn_body::bf16*)(AR + AR_Q); const attn_body::bf16* Kp = (const attn_body::bf16*)(AR + AR_K); const attn_body::bf16* Vp = (const attn_body::bf16*)(AR + AR_V);
            attn_body::bf16* O = (attn_body::bf16*)(AR + AR_O);
            const float lam_init = KLAM(j); const float* attn_lambda = KIN(6); const float* attn_subln = KIN(7);
            for (int bh = vcu; bh < BATCH * 8; bh += G) {
                const int b = bh >> 3, h = bh & 7;
                for (int ui = 0; ui < 32; ++ui) {
                    const int qb = 7 - (ui >> 2), map = (ui >> 1) & 1, half = ui & 1;
                    attn_body::attn_unit<8>(b, 2 * h + map, h * 128 + half * 64, h * 256 + map * 128 + half * 64, qb, Q, Kp, Vp, O, ldsg, tid);
                }
                VM_WAIT(); __syncthreads(); asm volatile("" : "+v"(tid)); tid &= 511;
                const int lane = tid & 63;
                const float* lam = attn_lambda + j * 256;
                const float la = wave_sum(lam[lane] * lam[64 + lane]), lb = wave_sum(lam[128 + lane] * lam[192 + lane]);
                const float lamf = __expf(la) - __expf(lb) + lam_init;
                const int sub = tid & 15; const float* sg = attn_subln + j * 128 + sub * 8;
                const f32x4 g0 = *(const f32x4*)sg, g1 = *(const f32x4*)(sg + 4);
                const bf16* Ob = (const bf16*)(AR + AR_O); bf16* OC = (bf16*)(AR + AR_Q);
                for (int ps = 0; ps < 64; ++ps) {
                    const size_t row = (size_t)b * SEQ + ps * 32 + (tid >> 4);
                    const v4u a1 = *(const v4u*)(Ob + row * 2048 + h * 256 + sub * 8), a2 = *(const v4u*)(Ob + row * 2048 + h * 256 + 128 + sub * 8);
                    f32x4 o0, o1;
                    o0[0] = bflo(a1.x) - lamf * bflo(a2.x); o0[1] = bfhi(a1.x) - lamf * bfhi(a2.x); o0[2] = bflo(a1.y) - lamf * bflo(a2.y); o0[3] = bfhi(a1.y) - lamf * bfhi(a2.y);
                    o1[0] = bflo(a1.z) - lamf * bflo(a2.z); o1[1] = bfhi(a1.z) - lamf * bfhi(a2.z); o1[2] = bflo(a1.w) - lamf * bflo(a2.w); o1[3] = bfhi(a1.w) - lamf * bfhi(a2.w);
                    float ss = (o0[0] * o0[0] + o0[1] * o0[1]) + (o0[2] * o0[2] + o0[3] * o0[3]) + (o1[0] * o1[0] + o1[1] * o1[1]) + (o1[2] * o1[2] + o1[3] * o1[3]);
                    ss += __shfl_xor(ss, 1); ss += __shfl_xor(ss, 2); ss += __shfl_xor(ss, 4); ss += __shfl_xor(ss, 8);
                    const float rs = __builtin_amdgcn_rsqf(ss * (1.0f / 128.0f) + 1e-5f) * (1.0f - lam_init);
                    o0 = o0 * g0 * rs; o1 = o1 * g1 * rs;
                    *(v4u*)(OC + row * 1024 + h * 128 + sub * 8) = (v4u){pk2(o0[0], o0[1]), pk2(o0[2], o0[3]), pk2(o1[0], o1[1]), pk2(o1[2], o1[3])};
                }
                __syncthreads();
            }
        }
}

__global__ void __launch_bounds__(NWAVES * 64, 2) trunk_fwd(Params p) {
    extern __shared__ __attribute__((aligned(16))) unsigned char lds[];
    cg::grid_group grid = cg::this_grid();
    LAS unsigned char* const L = (LAS unsigned char*)lds;
    const int G = gridDim.x; const int bx = blockIdx.x; const int vcu = (G % 8 == 0) ? (bx % 8) * (G / 8) + bx / 8 : bx;
    kaptr_t ka = (kaptr_t)__builtin_amdgcn_kernarg_segment_ptr();
    int tid = threadIdx.x;

    {
        LAUNDER(); WSPTRS();
        const int lane = tid & 63, wave = __builtin_amdgcn_readfirstlane(tid >> 6);
        const float* x_in = KIN(0); const int* positions = (const int*)KIN(1); const float* mix_norm = KIN(2); const float* ffn_norm = KIN(3);
        const float* attn_w_in = KIN(5); const float* attn_w_out = KIN(8); const float* gmlp_w_in = KIN(9); const float* gmlp_w_s = KIN(13); const float* gmlp_w_out = KIN(15);
        const float* conv_w_in = KIN(16); const float* conv_w_out = KIN(18); const float* ffn_w_gu = KIN(19); const float* ffn_w_dn = KIN(20);
        bf16* const W_ATT_IN = (bf16*)(ws + WS_W_ATT_IN); bf16* const W_ATT_OUT = (bf16*)(ws + WS_W_ATT_OUT); bf16* const W_G_IN = (bf16*)(ws + WS_W_G_IN); bf16* const W_G_OUT = (bf16*)(ws + WS_W_G_OUT);
        bf16* const W_C_IN = (bf16*)(ws + WS_W_C_IN); bf16* const W_C_OUT = (bf16*)(ws + WS_W_C_OUT); bf16* const W_GU = (bf16*)(ws + WS_W_GU); bf16* const W_DN = (bf16*)(ws + WS_W_DN); bf16* const WSB = (bf16*)(ws + WS_WSB);
        f32x2* const ROPE = (f32x2*)(ws + WS_ROPE);
        LAS float* scr = (LAS float*)(L + wave * 16384);
        const int gw = vcu * NWAVES + wave, NGW = G * NWAVES;
        constexpr int I_AIN = 16 * 96, I_AOUT = 16 * 32, I_GOUT = 24 * 32, I_GU = 16 * 176, I_DN = 44 * 32;
        constexpr int NITEMS = 2 * I_AIN + 2 * I_AOUT + I_AIN + I_GOUT + I_AIN + I_AOUT + 4 * I_GU + 4 * I_DN;
        for (int it = gw; it < NITEMS; it += NGW) {
            int r = it;
            if (r < 2 * I_AIN) { const int j = r / I_AIN; p0_item(attn_w_in + (size_t)j * 3145728, 1024, 3072, W_ATT_IN + (size_t)j * 3145728, mix_norm + (j ? 3 : 0) * 1024, 1, scr, r % I_AIN, lane); continue; } r -= 2 * I_AIN;
            if (r < 2 * I_AOUT) { const int j = r / I_AOUT; p0_item(attn_w_out + (size_t)j * 1048576, 1024, 1024, W_ATT_OUT + (size_t)j * 1048576, nullptr, 0, scr, r % I_AOUT, lane); continue; } r -= 2 * I_AOUT;
            if (r < I_AIN) { p0_item(gmlp_w_in, 1024, 3072, W_G_IN, mix_norm + 1024, 0, scr, r, lane); continue; } r -= I_AIN;
            if (r < I_GOUT) { p0_item(gmlp_w_out, 1536, 1024, W_G_OUT, nullptr, 0, scr, r, lane); continue; } r -= I_GOUT;
            if (r < I_AIN) { p0_item(conv_w_in, 1024, 3072, W_C_IN, mix_norm + 2048, 3, scr, r, lane); continue; } r -= I_AIN;
            if (r < I_AOUT) { p0_item(conv_w_out, 1024, 1024, W_C_OUT, nullptr, 0, scr, r, lane); continue; } r -= I_AOUT;
            if (r < 4 * I_GU) { const int j = r / I_GU; p0_item(ffn_w_gu + (size_t)j * 5767168, 1024, 5632, W_GU + (size_t)j * 5767168, ffn_norm + j * 1024, 2, scr, r % I_GU, lane); continue; } r -= 4 * I_GU;
            { const int j = r / I_DN; p0_item(ffn_w_dn + (size_t)j * 2883584, 2816, 1024, W_DN + (size_t)j * 2883584, nullptr, 0, scr, r % I_DN, lane); }
        }
        const int gt = vcu * (NWAVES * 64) + tid, NGT = G * NWAVES * 64;
        for (int i = gt; i < 8 * 128 * 128; i += NGT) { const int s = i & 127, t = (i >> 7) & 127; WSB[i] = (s <= t) ? (bf16)f2bf(gmlp_w_s[i]) : (bf16)0; }
        for (int i = gt; i < M * 32; i += NGT) {
            const int d = i & 31, tok = i >> 5;
            const double inv = exp2(-(double)d * 0.41524101186092029);
            double rev = (double)positions[tok] * inv * 0.15915494309189535; rev -= floor(rev);
            const float r = (float)rev;
            ROPE[i] = (f32x2){__builtin_amdgcn_cosf(r), __builtin_amdgcn_sinf(r)};
        }
        for (int m = gw; m < M; m += NGW) {
            const f32x4* xr = (const f32x4*)(x_in + (size_t)m * D) + lane; f32x4 v[4]; float s = 0.f;
#pragma unroll
            for (int j = 0; j < 4; ++j) { v[j] = xr[64 * j]; s += (v[j][0] * v[j][0] + v[j][1] * v[j][1]) + (v[j][2] * v[j][2] + v[j][3] * v[j][3]); }
            s = wave_sum(s);
            v2u* o8 = (v2u*)(XB + (size_t)m * D) + lane;
#pragma unroll
            for (int j = 0; j < 4; ++j) o8[64 * j] = (v2u){pk2(v[j][0], v[j][1]), pk2(v[j][2], v[j][3])};
            if (lane < 16) SSQ[(size_t)m * 16 + lane] = (lane == 0) ? s : 0.f;
        }
    }
    grid.sync();

#ifndef DBG_NO_LIGHT
    light_step(0, ka, tid, L, G, bx, vcu); grid.sync();
#endif
#ifndef DBG_NO_ATTN
    attn_step(0, ka, tid, (char*)lds, G, vcu); grid.sync();
#endif
#ifndef DBG_NO_LIGHT
    for (int step = 2; step < 16; ++step) { light_step(step, ka, tid, L, G, bx, vcu); grid.sync(); }
#endif
#ifndef DBG_NO_ATTN2
    attn_step(1, ka, tid, (char*)lds, G, vcu); grid.sync();
#endif
#ifndef DBG_NO_LIGHT
    for (int step = 17; step < 20; ++step) { light_step(step, ka, tid, L, G, bx, vcu); grid.sync(); }
#endif

    {
        LAUNDER();
        const int lane = tid & 63, wave = __builtin_amdgcn_readfirstlane(tid >> 6); float* const out = KOUT; const float* final_norm = KIN(4);
        const int gw = vcu * NWAVES + wave, NGW = G * NWAVES;
        f32x4 gn[4];
#pragma unroll
        for (int jj = 0; jj < 4; ++jj) gn[jj] = *((const f32x4*)final_norm + lane + 64 * jj);
        for (int m = gw; m < M; m += NGW) {
            f32x4* xr = (f32x4*)(out + (size_t)m * D) + lane; f32x4 v[4]; float s = 0.f;
#pragma unroll
            for (int jj = 0; jj < 4; ++jj) { v[jj] = xr[64 * jj]; s += (v[jj][0] * v[jj][0] + v[jj][1] * v[jj][1]) + (v[jj][2] * v[jj][2] + v[jj][3] * v[jj][3]); }
            const float rs = __builtin_amdgcn_rsqf(wave_sum(s) * (1.0f / 1024.0f) + 1e-6f);
#pragma unroll
            for (int jj = 0; jj < 4; ++jj) xr[64 * jj] = v[jj] * rs * gn[jj];
        }
    }
}

extern "C" void kernel_launch(void* const* d_in, const int* in_sizes, int n_in, void* d_out, int out_size, void* d_ws, size_t ws_size, hipStream_t stream) {
    static int grid = 0;
    if (grid == 0) {
        if (n_in != 21 || in_sizes[0] != M * D || out_size != M * D || ws_size < WS_END) { fprintf(stderr, "kernel_launch: unexpected shapes (n_in %d, in0 %d, out %d, ws %zu)\n", n_in, n_in > 0 ? in_sizes[0] : -1, out_size, ws_size); grid = -1; return; }
        int dev = 0, cus = 0, per_cu = 0;
        if (hipGetDevice(&dev) != hipSuccess || hipDeviceGetAttribute(&cus, hipDeviceAttributeMultiprocessorCount, dev) != hipSuccess) { grid = -1; return; }
        if (hipFuncSetAttribute((const void*)trunk_fwd, hipFuncAttributeMaxDynamicSharedMemorySize, LDS_BYTES) != hipSuccess) { fprintf(stderr, "kernel_launch: hipFuncSetAttribute failed\n"); grid = -1; return; }
        if (hipOccupancyMaxActiveBlocksPerMultiprocessor(&per_cu, (const void*)trunk_fwd, NWAVES * 64, LDS_BYTES) != hipSuccess || per_cu < 1) { fprintf(stderr, "kernel_launch: occupancy query says %d\n", per_cu); per_cu = 1; }
        (void)hipGetLastError();
        grid = cus;
    }
    if (grid < 0) return;
    Params p{};
    for (int i = 0; i < 21; ++i) p.in[i] = d_in[i];
    p.out = (float*)d_out; p.ws = (unsigned char*)d_ws;
    p.lam0 = (float)(0.8 - 0.6 * exp(-0.3 * 0.0)); p.lam1 = (float)(0.8 - 0.6 * exp(-0.3 * 3.0));
    void* args[] = {&p};
    const hipError_t e = hipLaunchCooperativeKernel((const void*)trunk_fwd, dim3(grid), dim3(NWAVES * 64), args, LDS_BYTES, stream);
    if (e != hipSuccess) fprintf(stderr, "kernel_launch: cooperative launch failed: %s (grid %d)\n", hipGetErrorString(e), grid);
}
```

```cpp
#include <hip/hip_runtime.h>
#include <hip/hip_cooperative_groups.h>
#include <cstdio>
#include <cstdint>
#include <cmath>
namespace pg8 {
#define PG8_LAS __attribute__((address_space(3)))
typedef unsigned short bf16_t;
typedef short bf16x8 __attribute__((ext_vector_type(8)));
typedef float f32x4 __attribute__((ext_vector_type(4)));
typedef unsigned u32x4 __attribute__((ext_vector_type(4)));
constexpr int BM = 256, BK = 64, HALF = 128, HTB = HALF * BK * 2  , STAGE_BYTES = 8 * HTB, NXCD = 8, WGM = 8;

__host__ __device__ __forceinline__ int lds_byte(int r, int c) { const int st = (r >> 4) * 2 + (c >> 5), rr = r & 15, cc = c & 31, ob = rr * 64 + cc * 2; return st * 1024 + (ob ^ (((ob >> 9) & 1) << 5)); }
__host__ __device__ __forceinline__ void stage_rc(int b, int& R, int& C) { const int st = b / 1024, sb = b % 1024, swz = sb ^ (((sb >> 9) & 1) << 5); R = (st >> 1) * 16 + swz / 64; C = (st & 1) * 32 + (swz % 64) / 2; }
__host__ __device__ __forceinline__ int perm32(int rho) { const int n = rho >> 4, i = rho & 15; return 8 * (i >> 2) + 4 * n + (i & 3); }

struct Unit { int pm, pn; };
struct Gemm { const bf16_t* A; const bf16_t* Bt; int M, N, K; };

struct StaticOrder {
    int nM, nN, nwg, G, c;
    __host__ __device__ void init(int M, int N, int G_, int c_) { nM = M / BM; nN = N / BM; nwg = nM * nN; G = G_; c = c_; }
    __host__ __device__ bool next(int i, Unit& u) const {
        const long L = (long)i * G + c; if (L >= nwg) return false;
        int wgid = (int)L; { const int q = nwg / NXCD, r = nwg % NXCD, xcd = wgid % NXCD, off = wgid / NXCD; wgid = (xcd < r ? xcd * (q + 1) : r * (q + 1) + (xcd - r) * q) + off; }
        const int nig = WGM * nN, gid = wgid / nig, fm = gid * WGM, gsz = (nM - fm) < WGM ? (nM - fm) : WGM;
        u.pm = fm + ((wgid % nig) % gsz); u.pn = (wgid % nig) / gsz; return true;
    }
    __device__ __forceinline__ void a_ready(const Unit&) const {}
    __device__ __forceinline__ void done(const Unit&) const {}
};
__device__ __forceinline__ unsigned cvt_pk_bf16(float lo, float hi) { unsigned r; asm volatile("v_cvt_pk_bf16_f32 %0, %1, %2" : "=v"(r) : "v"(lo), "v"(hi)); return r; }
typedef float f32x2 __attribute__((ext_vector_type(2)));
__device__ __forceinline__ f32x2 gelu_pk(f32x2 v) {
    const f32x2 av = __builtin_elementwise_abs(v), d = av * 0.2316418882f + 1.0f;
    f32x2 t; t.x = __builtin_amdgcn_rcpf(d.x); t.y = __builtin_amdgcn_rcpf(d.y);
    f32x2 q = t * 0.5307027145f + (-0.7265760135f); q = q * t + 0.7107068705f; q = q * t + (-0.142248368f); q = q * t + 0.127414796f; q = q * t;
    const f32x2 s = (v * v) * (-0.72134752044f);
    f32x2 e; e.x = __builtin_amdgcn_exp2f(s.x); e.y = __builtin_amdgcn_exp2f(s.y);
    const f32x2 m = v * (q * e), r = v - m;
    f32x2 o; o.x = v.x < 0.f ? m.x : r.x; o.y = v.y < 0.f ? m.y : r.y; return o;
}
constexpr float QK_C2 = 0.125f * 1.4426950408889634f;
typedef float f32x2e __attribute__((ext_vector_type(2)));
__device__ __forceinline__ u32x4 pack8(const f32x4 a, const f32x4 b) { u32x4 w; w.x = cvt_pk_bf16(a[0], a[1]); w.y = cvt_pk_bf16(a[2], a[3]); w.z = cvt_pk_bf16(b[0], b[1]); w.w = cvt_pk_bf16(b[2], b[3]); return w; }
__device__ __forceinline__ float quad_sum(float s) {
    { const auto a = __builtin_amdgcn_permlane16_swap(__float_as_uint(s), __float_as_uint(s), false, false); s = __uint_as_float(a[0]) + __uint_as_float(a[1]); }
    { const auto b = __builtin_amdgcn_permlane32_swap(__float_as_uint(s), __float_as_uint(s), false, false); s = __uint_as_float(b[0]) + __uint_as_float(b[1]); }
    return s; }
__device__ __forceinline__ void gelu8(f32x4& v0, f32x4& v1) {
    const f32x4 a0 = __builtin_elementwise_abs(v0), a1 = __builtin_elementwise_abs(v1), d0 = a0 * 0.2316418882f + 1.0f, d1 = a1 * 0.2316418882f + 1.0f;
    f32x4 t0, t1;
#pragma unroll
    for (int e = 0; e < 4; ++e) { t0[e] = __builtin_amdgcn_rcpf(d0[e]); t1[e] = __builtin_amdgcn_rcpf(d1[e]); }
    f32x4 q0 = t0 * 0.5307027145f + (-0.7265760135f), q1 = t1 * 0.5307027145f + (-0.7265760135f);
    q0 = q0 * t0 + 0.7107068705f; q1 = q1 * t1 + 0.7107068705f; q0 = q0 * t0 + (-0.142248368f); q1 = q1 * t1 + (-0.142248368f);
    q0 = q0 * t0 + 0.127414796f; q1 = q1 * t1 + 0.127414796f; q0 = q0 * t0; q1 = q1 * t1;
    const f32x4 s0 = (v0 * v0) * (-0.72134752044f), s1 = (v1 * v1) * (-0.72134752044f);
    f32x4 e0, e1;
#pragma unroll
    for (int e = 0; e < 4; ++e) { e0[e] = __builtin_amdgcn_exp2f(s0[e]); e1[e] = __builtin_amdgcn_exp2f(s1[e]); }
    const f32x4 m0 = v0 * (q0 * e0), m1 = v1 * (q1 * e1), r0 = v0 - m0, r1 = v1 - m1;
#pragma unroll
    for (int e = 0; e < 4; ++e) { const float x0 = v0[e], x1 = v1[e]; v0[e] = x0 < 0.f ? m0[e] : r0[e]; v1[e] = x1 < 0.f ? m1[e] : r1[e]; }
}
struct EpiGen {
    static constexpr bool PERM = true, AFTER_DRAIN = false;
    int mode;
    float* ssq;
    float eps;
    bf16_t *o0, *o1, *o2;
    const int* pos;
    const float* bias;
    f32x2e* vstat;
    float* xout; const bf16_t* xb;
    __device__ __forceinline__ float row_rstd(int row, int fq) const {
        const f32x4 p = *(const f32x4*)(ssq + (size_t)row * 16 + fq * 4);
        const float s = quad_sum((p[0] + p[1]) + (p[2] + p[3]));
        return __builtin_amdgcn_rsqf(s * (1.0f / 1024.0f) + eps);
    }
    __device__ __forceinline__ void operator()(const f32x4 (&acc)[2][2][4][2], const Unit& u, int wr, int wc, int fr, int fq) const {
        asm volatile("" : "+v"(fr), "+v"(fq));
        const int rowb = u.pm * BM + wr * 64 + fr, pn = u.pn;
        float rsv[2][4];
        if (mode != 3) { f32x4 pp[2][4];
#pragma unroll
            for (int ai = 0; ai < 2; ++ai)
#pragma unroll
                for (int m = 0; m < 4; ++m) pp[ai][m] = *(const f32x4*)(ssq + (size_t)(rowb + ai * HALF + m * 16) * 16 + fq * 4);
#pragma unroll
            for (int ai = 0; ai < 2; ++ai)
#pragma unroll
                for (int m = 0; m < 4; ++m) rsv[ai][m] = __builtin_amdgcn_rsqf(quad_sum((pp[ai][m][0] + pp[ai][m][1]) + (pp[ai][m][2] + pp[ai][m][3])) * (1.0f / 1024.0f) + eps); }
        if (mode == 3) {
            const int col0 = pn * BM + wc * 32 + 8 * fq;
            u32x4 xw[8][2];
#pragma unroll
            for (int k = 0; k < 4; ++k)
#pragma unroll
                for (int bj = 0; bj < 2; ++bj) xw[k][bj] = *(const u32x4*)(xb + (size_t)(rowb + k * 16) * 1024 + col0 + bj * HALF);
#pragma unroll
            for (int k = 0; k < 8; ++k) {
                    const int ai = k >> 2, m = k & 3;
                    const int row = rowb + ai * HALF + m * 16; const size_t off = (size_t)row * 1024 + col0; float sq = 0.f;
                    const u32x4 w0 = xw[k][0], w1 = xw[k][1];
                    if (k < 4) {
#pragma unroll
                        for (int bj = 0; bj < 2; ++bj) xw[k + 4][bj] = *(const u32x4*)(xb + (size_t)(rowb + HALF + k * 16) * 1024 + col0 + bj * HALF);
                    }
#pragma unroll
                    for (int bj = 0; bj < 2; ++bj) {
                        const u32x4 w = bj ? w1 : w0;
                        const f32x4 x0 = (f32x4){__uint_as_float(w.x << 16), __uint_as_float(w.x & 0xffff0000u), __uint_as_float(w.y << 16), __uint_as_float(w.y & 0xffff0000u)};
                        const f32x4 x1 = (f32x4){__uint_as_float(w.z << 16), __uint_as_float(w.z & 0xffff0000u), __uint_as_float(w.w << 16), __uint_as_float(w.w & 0xffff0000u)};
                        const f32x4 v0 = x0 + acc[ai][bj][m][0], v1 = x1 + acc[ai][bj][m][1];
                        if (xout) { *(f32x4*)(xout + off + bj * HALF) = v0; *(f32x4*)(xout + off + bj * HALF + 4) = v1; }
                        sq += (v0[0] * v0[0] + v0[1] * v0[1]) + (v0[2] * v0[2] + v0[3] * v0[3]) + (v1[0] * v1[0] + v1[1] * v1[1]) + (v1[2] * v1[2] + v1[3] * v1[3]);
                        if (o0) *(u32x4*)(o0 + off + bj * HALF) = pack8(v0, v1);
                    }
                    sq = quad_sum(sq);
                    if (fq == 0) ssq[(size_t)row * 16 + pn * 4 + wc] = sq;
                }
        } else if (mode == 4) {
            const int col0 = pn * HALF + wc * 32 + 8 * fq;
#pragma unroll
            for (int ai = 0; ai < 2; ++ai)
#pragma unroll
                for (int m = 0; m < 4; ++m) {
                    const int row = rowb + ai * HALF + m * 16; const float rs = rsv[ai][m]; f32x4 h[2];
                    const float rsc = rs * -1.4426950408889634f, rs2 = rs * rs;
                    const f32x4 a0 = acc[ai][0][m][0], a1 = acc[ai][0][m][1], b0 = acc[ai][1][m][0], b1 = acc[ai][1][m][1];
                    const f32x4 t0 = a0 * rsc, t1 = a1 * rsc; f32x4 e0, e1;
#pragma unroll
                    for (int e = 0; e < 4; ++e) { e0[e] = __builtin_amdgcn_exp2f(t0[e]); e1[e] = __builtin_amdgcn_exp2f(t1[e]); }
                    const f32x4 d0 = e0 + 1.0f, d1 = e1 + 1.0f, p0 = (a0 * b0) * rs2, p1 = (a1 * b1) * rs2; f32x4 r0, r1;
#pragma unroll
                    for (int e = 0; e < 4; ++e) { r0[e] = __builtin_amdgcn_rcpf(d0[e]); r1[e] = __builtin_amdgcn_rcpf(d1[e]); }
                    h[0] = p0 * r0; h[1] = p1 * r1;
                    *(u32x4*)(o0 + (size_t)row * 2816 + col0) = pack8(h[0], h[1]);
                }
        } else if (mode == 0) {
            if (pn < 8) {
                bf16_t* dst = (pn < 4) ? o0 : o1; const float sc = (pn < 4) ? QK_C2 : 1.0f; const int head = (pn & 3) * 4 + wc;
                int posv[2][4];
#pragma unroll
                for (int ai = 0; ai < 2; ++ai)
#pragma unroll
                    for (int m = 0; m < 4; ++m) posv[ai][m] = pos[rowb + ai * HALF + m * 16];
                f32x4 iva, ivb;
#pragma unroll
                for (int e = 0; e < 4; ++e) { iva[e] = __builtin_amdgcn_exp2f(-(float)(8 * fq + e) * 0.41524101186092029f) * 0.15915494309189535f; ivb[e] = __builtin_amdgcn_exp2f(-(float)(8 * fq + 4 + e) * 0.41524101186092029f) * 0.15915494309189535f; }
#pragma unroll
                for (int ai = 0; ai < 2; ++ai)
#pragma unroll
                    for (int m = 0; m < 4; ++m) {
                        const int row = rowb + ai * HALF + m * 16; const float rs = rsv[ai][m] * sc; const float pf = (float)posv[ai][m];
                        f32x4 ca, cb, sa, sb;
#pragma unroll
                        for (int e = 0; e < 4; ++e) { const float ra = __builtin_amdgcn_fractf(pf * iva[e]), rb = __builtin_amdgcn_fractf(pf * ivb[e]);
                            ca[e] = __builtin_amdgcn_cosf(ra); sa[e] = __builtin_amdgcn_sinf(ra); cb[e] = __builtin_amdgcn_cosf(rb); sb[e] = __builtin_amdgcn_sinf(rb); }
                        const f32x4 x1a = acc[ai][0][m][0] * rs, x1b = acc[ai][0][m][1] * rs, x2a = acc[ai][1][m][0] * rs, x2b = acc[ai][1][m][1] * rs;
                        const f32x4 o1a = x1a * ca - x2a * sa, o1b = x1b * cb - x2b * sb, o2a = x2a * ca + x1a * sa, o2b = x2b * cb + x1b * sb;
                        bf16_t* p = dst + (size_t)row * 1024 + head * 64 + 8 * fq;
                        *(u32x4*)p = pack8(o1a, o1b); *(u32x4*)(p + 32) = pack8(o2a, o2b);
                    }
            } else {
                const int col0 = (pn - 8) * BM + wc * 32 + 8 * fq;
#pragma unroll
                for (int ai = 0; ai < 2; ++ai)
#pragma unroll
                    for (int m = 0; m < 4; ++m) {
                        const int row = rowb + ai * HALF + m * 16; const float rs = rsv[ai][m];
#pragma unroll
                        for (int bj = 0; bj < 2; ++bj) *(u32x4*)(o2 + (size_t)row * 1024 + col0 + bj * HALF) = pack8(acc[ai][bj][m][0] * rs, acc[ai][bj][m][1] * rs);
                    }
            }
        } else if (mode == 1) {
            const int col0 = pn * BM + wc * 32 + 8 * fq; const bool isv = pn >= 6;
            bf16_t* dst = isv ? (o1 + col0 - 1536) : (o0 + col0);
            f32x4 bv[2][2];
#pragma unroll
            for (int bj = 0; bj < 2; ++bj)
#pragma unroll
                for (int n = 0; n < 2; ++n) bv[bj][n] = *(const f32x4*)(bias + col0 + bj * HALF + 4 * n);
#pragma unroll
            for (int ai = 0; ai < 2; ++ai)
#pragma unroll
                for (int m = 0; m < 4; ++m) {
                    const int row = rowb + ai * HALF + m * 16; const float rs = rsv[ai][m]; float s1 = 0.f, s2 = 0.f;
#pragma unroll
                    for (int bj = 0; bj < 2; ++bj) {
                        f32x4 v0 = acc[ai][bj][m][0] * rs + bv[bj][0], v1 = acc[ai][bj][m][1] * rs + bv[bj][1];
                        gelu8(v0, v1);
                        s1 += ((v0[0] + v0[1]) + (v0[2] + v0[3])) + ((v1[0] + v1[1]) + (v1[2] + v1[3]));
                        s2 += (v0[0] * v0[0] + v0[1] * v0[1]) + (v0[2] * v0[2] + v0[3] * v0[3]) + (v1[0] * v1[0] + v1[1] * v1[1]) + (v1[2] * v1[2] + v1[3] * v1[3]);
                        *(u32x4*)(dst + (size_t)row * 1536 + bj * HALF) = pack8(v0, v1);
                    }
                    if (isv) { s1 = quad_sum(s1); s2 = quad_sum(s2); if (fq == 0) vstat[(size_t)row * 24 + (pn - 6) * 4 + wc] = (f32x2e){s1, s2}; }
                }
        } else {
#pragma unroll
            for (int ai = 0; ai < 2; ++ai)
#pragma unroll
                for (int m = 0; m < 4; ++m) {
                    const int row = rowb + ai * HALF + m * 16; const float rs = rsv[ai][m];
                    if (pn < 4) {
#pragma unroll
                        for (int bj = 0; bj < 2; ++bj) *(u32x4*)(o0 + (size_t)row * 1024 + pn * BM + wc * 32 + 8 * fq + bj * HALF) = pack8(acc[ai][bj][m][0] * rs, acc[ai][bj][m][1] * rs);
                    } else {
                        const float r2 = rs * rs;
                        *(u32x4*)(o1 + (size_t)row * 1024 + (pn - 4) * HALF + wc * 32 + 8 * fq) = pack8(acc[ai][0][m][0] * acc[ai][1][m][0] * r2, acc[ai][0][m][1] * acc[ai][1][m][1] * r2);
                    }
                }
        }
    }
};

template <class Epi, class Sched, bool ALIGN_EPI = false, bool SP2 = false>
__device__ __forceinline__ void gemm_phase(PG8_LAS unsigned char* lds, const Gemm g, const Sched& S, const Epi& E, const int tid) {
    const int wid = __builtin_amdgcn_readfirstlane(tid >> 6), lane = tid & 63, wr = wid >> 2, wc = wid & 3, fr = lane & 15, fq = lane >> 4;
    const int K = g.K, nt = K / BK;
    unsigned voffA[2], voffB[2];
#pragma unroll
    for (int i = 0; i < 2; ++i) { int R, C; stage_rc(tid * 16 + i * 8192, R, C); const int Rb = Epi::PERM ? ((R & ~31) + perm32(R & 31)) : R;
        voffA[i] = (unsigned)(R * K + C) * 2u; voffB[i] = (unsigned)(Rb * K + C) * 2u; }
    const size_t kstep = (size_t)(BK * 2);
    const size_t hstep = (size_t)HALF * K * 2;
    const size_t tstep = 2 * hstep;
    const unsigned ldsw = (unsigned)wid * 1024u;
    const int aoff = lds_byte(wr * 64 + fr, fq * 8), boff = lds_byte(wc * 32 + fr, fq * 8);
#define PG8_SA(b, h) (((b) * 2 + (h)) * HTB)
#define PG8_SB(b, h) ((4 + (b) * 2 + (h)) * HTB)
#define PG8_STAGE(bufoff, gbase, voff) do { _Pragma("unroll") for (int _i = 0; _i < 2; ++_i) \
        __builtin_amdgcn_global_load_lds((const unsigned*)((const char*)(gbase) + (voff)[_i]), (PG8_LAS unsigned*)(lds + (bufoff) + ldsw + _i * 8192), 16, 0, 0); } while (0)
#define PG8_LDA(dst, b, h) do { _Pragma("unroll") for (int m = 0; m < 4; ++m) _Pragma("unroll") for (int k = 0; k < 2; ++k) dst[m][k] = *(const PG8_LAS bf16x8*)(lds + PG8_SA(b, h) + aoff + m * 2048 + k * 1024); } while (0)
#define PG8_LDB(dst, b, h) do { _Pragma("unroll") for (int n = 0; n < 2; ++n) _Pragma("unroll") for (int k = 0; k < 2; ++k) dst[n][k] = *(const PG8_LAS bf16x8*)(lds + PG8_SB(b, h) + boff + n * 2048 + k * 1024); } while (0)
#define PG8_MMA(ai, bj, At, Bt) do { __builtin_amdgcn_s_setprio(1); _Pragma("unroll") for (int m = 0; m < 4; ++m) _Pragma("unroll") for (int n = 0; n < 2; ++n) _Pragma("unroll") for (int k = 0; k < 2; ++k) \
        acc[ai][bj][m][n] = __builtin_amdgcn_mfma_f32_16x16x32_bf16(Bt[n][k], At[m][k], acc[ai][bj][m][n], 0, 0, 0); __builtin_amdgcn_s_setprio(0); } while (0)
#define PG8_WAIT_V(n) asm volatile("s_waitcnt vmcnt(" #n ")" ::: "memory")
#define PG8_WAIT_L(n) asm volatile("s_waitcnt lgkmcnt(" #n ")" ::: "memory")
#define PG8_BAR __builtin_amdgcn_s_barrier()
#define PG8_SCHED __builtin_amdgcn_sched_barrier(0)
    Unit cur, nxt; int ui = 0;
    if (!S.next(0, cur)) return;
    f32x4 acc[2][2][4][2];
#pragma unroll
    for (int a = 0; a < 2; ++a)
#pragma unroll
        for (int b = 0; b < 2; ++b)
#pragma unroll
            for (int m = 0; m < 4; ++m)
#pragma unroll
                for (int n = 0; n < 2; ++n) acc[a][b][m][n] = (f32x4){0.f, 0.f, 0.f, 0.f};
    bf16x8 At[4][2], B0[2][2], B1[2][2];
    const char* cA = (const char*)g.A + (size_t)cur.pm * tstep; const char* cB = (const char*)g.Bt + (size_t)cur.pn * tstep;
    S.a_ready(cur);
    if constexpr (SP2) {
        PG8_STAGE(PG8_SB(0, 0), cB, voffB); PG8_STAGE(PG8_SB(0, 1), cB + hstep, voffB); PG8_STAGE(PG8_SA(0, 0), cA, voffA); PG8_STAGE(PG8_SA(0, 1), cA + hstep, voffA);
        if (wr == 1) PG8_BAR;
        PG8_WAIT_V(2); PG8_BAR;
        PG8_STAGE(PG8_SB(1, 0), cB + kstep, voffB); PG8_STAGE(PG8_SA(1, 0), cA + kstep, voffA); PG8_STAGE(PG8_SB(1, 1), cB + hstep + kstep, voffB);
        PG8_WAIT_V(6); PG8_BAR;
    } else {
        PG8_STAGE(PG8_SB(0, 0), cB, voffB); PG8_STAGE(PG8_SA(0, 0), cA, voffA); PG8_STAGE(PG8_SB(0, 1), cB + hstep, voffB); PG8_STAGE(PG8_SA(0, 1), cA + hstep, voffA);
        if (wr == 1) PG8_BAR;
        PG8_WAIT_V(4); PG8_BAR;
        PG8_STAGE(PG8_SB(1, 0), cB + kstep, voffB); PG8_STAGE(PG8_SA(1, 0), cA + kstep, voffA); PG8_STAGE(PG8_SB(1, 1), cB + hstep + kstep, voffB);
        PG8_WAIT_V(6); PG8_BAR;
    }
    for (;;) {
        const bool has_next = S.next(ui + 1, nxt);
        const char* nA = has_next ? (const char*)g.A + (size_t)nxt.pm * tstep : cA; const char* nB = has_next ? (const char*)g.Bt + (size_t)nxt.pn * tstep : cB;
        for (int t = 0; t < nt; t += 2) {
            const bool last = (t == nt - 2);
            const char* a1 = cA + (size_t)(t + 1) * kstep;
            const char* a2 = last ? nA : cA + (size_t)(t + 2) * kstep; const char* b2 = last ? nB : cB + (size_t)(t + 2) * kstep;
            const char* a3 = a2 + kstep; const char* b3 = b2 + kstep;
            if (last && has_next) S.a_ready(nxt);
            if constexpr (SP2) {
            PG8_LDB(B0, 0, 0); PG8_LDB(B1, 0, 1); PG8_SCHED; PG8_LDA(At, 0, 0); PG8_STAGE(PG8_SA(1, 1), a1 + hstep, voffA);
            PG8_WAIT_V(8); PG8_WAIT_L(0); PG8_BAR; PG8_MMA(0, 0, At, B0); PG8_MMA(0, 1, At, B1); PG8_BAR; PG8_SCHED;
            PG8_LDA(At, 0, 1); PG8_STAGE(PG8_SB(0, 0), b2, voffB); PG8_STAGE(PG8_SB(0, 1), b2 + hstep, voffB); PG8_STAGE(PG8_SA(0, 0), a2, voffA);
            PG8_WAIT_V(8); PG8_WAIT_L(0); PG8_BAR; PG8_MMA(1, 0, At, B0); PG8_MMA(1, 1, At, B1); PG8_BAR; PG8_SCHED;
            PG8_LDB(B0, 1, 0); PG8_LDB(B1, 1, 1); PG8_SCHED; PG8_LDA(At, 1, 0); PG8_STAGE(PG8_SA(0, 1), a2 + hstep, voffA);
            PG8_WAIT_V(8); PG8_WAIT_L(0); PG8_BAR; PG8_MMA(0, 0, At, B0); PG8_MMA(0, 1, At, B1); PG8_BAR; PG8_SCHED;
            PG8_LDA(At, 1, 1); PG8_STAGE(PG8_SB(1, 0), b3, voffB); PG8_STAGE(PG8_SB(1, 1), b3 + hstep, voffB); PG8_STAGE(PG8_SA(1, 0), a3, voffA);
            PG8_WAIT_V(8); PG8_WAIT_L(0); PG8_BAR; PG8_MMA(1, 0, At, B0); PG8_MMA(1, 1, At, B1); PG8_BAR; PG8_SCHED;
            } else {
            PG8_LDB(B0, 0, 0); PG8_SCHED; PG8_LDA(At, 0, 0); PG8_STAGE(PG8_SA(1, 1), a1 + hstep, voffA);
            PG8_WAIT_L(8); PG8_BAR; PG8_WAIT_L(0); PG8_MMA(0, 0, At, B0); PG8_BAR; PG8_SCHED;
            PG8_LDB(B1, 0, 1); PG8_STAGE(PG8_SB(0, 0), b2, voffB);
            PG8_BAR; PG8_WAIT_L(0); PG8_MMA(0, 1, At, B1); PG8_BAR;
            PG8_LDA(At, 0, 1); PG8_STAGE(PG8_SA(0, 0), a2, voffA);
            PG8_BAR; PG8_WAIT_L(0); PG8_MMA(1, 0, At, B0); PG8_BAR; PG8_SCHED;
            PG8_STAGE(PG8_SB(0, 1), b2 + hstep, voffB);
            PG8_WAIT_V(6); PG8_BAR; PG8_MMA(1, 1, At, B1); PG8_BAR;
            PG8_LDB(B0, 1, 0); PG8_SCHED; PG8_LDA(At, 1, 0); PG8_STAGE(PG8_SA(0, 1), a2 + hstep, voffA);
            PG8_WAIT_L(8); PG8_BAR; PG8_WAIT_L(0); PG8_MMA(0, 0, At, B0); PG8_BAR; PG8_SCHED;
            PG8_LDB(B1, 1, 1); PG8_STAGE(PG8_SB(1, 0), b3, voffB);
            PG8_BAR; PG8_WAIT_L(0); PG8_MMA(0, 1, At, B1); PG8_BAR;
            PG8_LDA(At, 1, 1); PG8_STAGE(PG8_SA(1, 0), a3, voffA);
            PG8_BAR; PG8_WAIT_L(0); PG8_MMA(1, 0, At, B0); PG8_BAR; PG8_SCHED;
            PG8_STAGE(PG8_SB(1, 1), b3 + hstep, voffB);
            PG8_WAIT_V(6); PG8_BAR; PG8_MMA(1, 1, At, B1); PG8_BAR;
            }
        }
        if constexpr (ALIGN_EPI) { if (wr == 0) PG8_BAR; }
        if constexpr (!Epi::AFTER_DRAIN) { E(acc, cur, wr, wc, fr, fq); S.done(cur); }
        if (!has_next) break;
#pragma unroll
        for (int a = 0; a < 2; ++a)
#pragma unroll
            for (int b = 0; b < 2; ++b)
#pragma unroll
                for (int m = 0; m < 4; ++m)
#pragma unroll
                    for (int n = 0; n < 2; ++n) acc[a][b][m][n] = (f32x4){0.f, 0.f, 0.f, 0.f};
        cur = nxt; cA = nA; cB = nB; ++ui;
        if constexpr (ALIGN_EPI) { if (wr == 1) PG8_BAR; }
    }
    PG8_WAIT_V(0);
    if constexpr (!ALIGN_EPI) { if (wr == 0) PG8_BAR; }
    PG8_BAR;
    if constexpr (Epi::AFTER_DRAIN) { E.fused(acc, cur, wr, wc, fr, fq, lds, wid, lane); S.done(cur); }
#undef PG8_SA
#undef PG8_SB
#undef PG8_STAGE
#undef PG8_LDA
#undef PG8_LDB
#undef PG8_MMA
#undef PG8_WAIT_V
#undef PG8_WAIT_L
#undef PG8_BAR
#undef PG8_SCHED
}
}
#include <hip/hip_bf16.h>
#include <cmath>
namespace attn_body {
using bf16=__hip_bfloat16;
using bf16x8=__attribute__((ext_vector_type(8)))short;
using s16x4=__attribute__((ext_vector_type(4)))short;
using f32x16=__attribute__((ext_vector_type(16)))float;
using u32x4=__attribute__((ext_vector_type(4)))unsigned;
constexpr int BATCH=32,NHEAD=16,SEQ=2048,D=64,DM=NHEAD*D,OPITCH=2048;
constexpr int NW=8,QBLK=32,QB=QBLK*NW,KVBLK=64,NQB=SEQ/QB;
constexpr int ATTN_PITCH=DM, ATTN_UNIT_ROWS=QB;
__device__ __forceinline__ int crow(int r,int hi){return (r&3)+8*(r>>2)+4*hi;}
#define SBAR() __builtin_amdgcn_sched_barrier(0)
__device__ __forceinline__ void cmask(f32x16&p0,f32x16&p1,int jb,int qrel,int hi){
  const float NEG=-INFINITY; int kb=64*jb+4*hi;
  #pragma unroll
  for(int r=0;r<16;++r){int kv=kb+(r&3)+8*(r>>2); if(kv>qrel)p0[r]=NEG; if(kv+32>qrel)p1[r]=NEG;}
}

constexpr int NSLOT=3, SLOTB=8192;
constexpr int LDS_K=0, LDS_V=NSLOT*SLOTB, LDS_WS=LDS_V+NSLOT*2*SLOTB, LDS_OST=LDS_WS+NW*64*4, LDS_BYTES=LDS_OST+NW*8192;
constexpr float C2=0.125f*1.4426950408889634f;
__device__ __forceinline__ void glds16(const void*gsrc,unsigned lds_dst){unsigned keep;
  asm volatile("s_mov_b32 %0, m0\n\ts_mov_b32 m0, %2\n\ts_nop 0\n\tglobal_load_lds_dwordx4 %1, off\n\ts_mov_b32 m0, %0":"=&s"(keep):"v"(gsrc),"s"(lds_dst):"memory");}
__device__ __forceinline__ float max3f(float a,float b,float c){float r;asm("v_max3_f32 %0, %1, %2, %3":"=v"(r):"v"(a),"v"(b),"v"(c));return r;}
__device__ __forceinline__ float max2f(float a,float b){float r;asm("v_max_f32_e32 %0, %1, %2":"=v"(r):"v"(a),"v"(b));return r;}
__device__ __forceinline__ float fadd_s(float a,float b){float r;asm("v_add_f32_e32 %0, %1, %2":"=v"(r):"v"(a),"v"(b));return r;}
__device__ __forceinline__ float fsub_s(float a,float b){float r;asm("v_sub_f32_e32 %0, %1, %2":"=v"(r):"v"(a),"v"(b));return r;}
typedef float f32x2_t __attribute__((ext_vector_type(2))); typedef __bf16 bf16x2_t __attribute__((ext_vector_type(2)));
__device__ __forceinline__ unsigned cvtpk_s(float lo,float hi){f32x2_t v={lo,hi};bf16x2_t b=__builtin_convertvector(v,bf16x2_t);return __builtin_bit_cast(unsigned,b);}
#define WAIT_BAR(N) asm volatile("s_waitcnt vmcnt(" #N ") lgkmcnt(0)\n\ts_barrier":::"memory")

__device__ __forceinline__ void qkt(f32x16&p0,f32x16&p1,const char*Kslot,const bf16x8*qr,const f32x16&negm,int r32,int hi){
  const char*kb=Kslot+hi*1024+r32*16;
  #pragma unroll
  for(int d0=0;d0<4;++d0){
    const bf16x8 b0=*reinterpret_cast<const bf16x8*>(kb+d0*2048);
    const bf16x8 b1=*reinterpret_cast<const bf16x8*>(kb+d0*2048+512);
    if(d0==0){p0=__builtin_amdgcn_mfma_f32_32x32x16_bf16(b0,qr[0],negm,0,0,0);p1=__builtin_amdgcn_mfma_f32_32x32x16_bf16(b1,qr[0],negm,0,0,0);}
    else{p0=__builtin_amdgcn_mfma_f32_32x32x16_bf16(b0,qr[d0],p0,0,0,0);p1=__builtin_amdgcn_mfma_f32_32x32x16_bf16(b1,qr[d0],p1,0,0,0);}}
}
typedef __attribute__((address_space(3))) const char* lds_cptr;
typedef short v4i16_t __attribute__((ext_vector_type(4)));
__device__ __forceinline__ void kload8(bf16x8*kf,lds_cptr kp){
  kf[0]=*(const __attribute__((address_space(3))) bf16x8*)(kp);      kf[1]=*(const __attribute__((address_space(3))) bf16x8*)(kp+512);
  kf[2]=*(const __attribute__((address_space(3))) bf16x8*)(kp+2048); kf[3]=*(const __attribute__((address_space(3))) bf16x8*)(kp+2560);
  kf[4]=*(const __attribute__((address_space(3))) bf16x8*)(kp+4096); kf[5]=*(const __attribute__((address_space(3))) bf16x8*)(kp+4608);
  kf[6]=*(const __attribute__((address_space(3))) bf16x8*)(kp+6144); kf[7]=*(const __attribute__((address_space(3))) bf16x8*)(kp+6656);
}
__device__ __forceinline__ void kload2(bf16x8*kf,lds_cptr kp,int j){ kf[2*j]=*(const __attribute__((address_space(3))) bf16x8*)(kp+j*2048); kf[2*j+1]=*(const __attribute__((address_space(3))) bf16x8*)(kp+j*2048+512); }
__device__ __forceinline__ s16x4 vtr(lds_cptr p){ return __builtin_bit_cast(s16x4,__builtin_amdgcn_ds_read_tr16_b64_v4i16((__attribute__((address_space(3))) v4i16_t*)p)); }
__device__ __forceinline__ float rowmax(const f32x16&p0,const f32x16&p1){
  float a=max3f(p0[0],p0[1],p1[0]),b=max3f(p0[2],p0[3],p1[1]);a=max3f(a,p1[2],p1[3]);
  #pragma unroll
  for(int r=4;r<16;r+=4){a=max3f(a,p0[r],p0[r+1]);b=max3f(b,p0[r+2],p0[r+3]);a=max3f(a,p1[r],p1[r+1]);b=max3f(b,p1[r+2],p1[r+3]);}
  const float m=max2f(a,b);
  auto rr=__builtin_amdgcn_permlane32_swap(__float_as_uint(m),__float_as_uint(m),false,false);
  return max2f(__uint_as_float(rr[0]),__uint_as_float(rr[1]));
}
__device__ __forceinline__ void pv(f32x16*o,int vb,bf16x8 pa0,bf16x8 pa1,bf16x8 pa2,bf16x8 pa3){
  #pragma unroll
  for(int d0=0;d0<4;++d0){s16x4 lo[4],hi[4];
    #pragma unroll
    for(int ks=0;ks<4;++ks){
      asm volatile("ds_read_b64_tr_b16 %0,%1 offset:%c2":"=&v"(lo[ks]):"v"(vb),"i"(d0*4096+ks*1024):"memory");
      asm volatile("ds_read_b64_tr_b16 %0,%1 offset:%c2":"=&v"(hi[ks]):"v"(vb),"i"(d0*4096+ks*1024+512):"memory");}
    asm volatile("s_waitcnt lgkmcnt(0)":::"memory");SBAR();
    #define PK(k) (bf16x8){lo[k][0],lo[k][1],lo[k][2],lo[k][3],hi[k][0],hi[k][1],hi[k][2],hi[k][3]}
    o[d0]=__builtin_amdgcn_mfma_f32_32x32x16_bf16(pa0,PK(0),o[d0],0,0,0);
    o[d0]=__builtin_amdgcn_mfma_f32_32x32x16_bf16(pa1,PK(1),o[d0],0,0,0);
    o[d0]=__builtin_amdgcn_mfma_f32_32x32x16_bf16(pa2,PK(2),o[d0],0,0,0);
    o[d0]=__builtin_amdgcn_mfma_f32_32x32x16_bf16(pa3,PK(3),o[d0],0,0,0);
    #undef PK
  }
}

#ifndef ATTN_STORE16
#define ATTN_STORE16(p,v) (*(u32x4*)(p)=(v))
#endif
template<int THRL> __device__ __forceinline__ void attn_unit(int b,int h,int vcol,int ocol,int qb,const bf16*Q,const bf16*__restrict__ K,const bf16*__restrict__ V,bf16*O,char*shm,const int tid_in,const bool fuse,const unsigned lamf_bits,const unsigned oscale_bits,const float*subln,bf16*OC,const int occol){
  int tid=tid_in; asm volatile("":"+v"(tid)); tid&=511;
  const int lane=tid&63,r32=lane&31,hi=lane>>5; const int wid=__builtin_amdgcn_readfirstlane(tid>>6);
  const long rowbase=(long)b*SEQ; const int q0=qb*QB;
  const bf16*Qw=Q+(rowbase+q0+wid*QBLK)*DM+h*D;
  const bf16*Kh=K+rowbase*DM+h*D,*Vh=V+rowbase*DM+vcol;
  const unsigned lds0=(unsigned)(uintptr_t)shm;
  float*wsf=(float*)(shm+LDS_WS)+wid*64;
  const bf16*ksrc=Kh+(long)lane*DM+wid*8;
  const bf16*vsrc=Vh+(long)(16*(wid&3)+(lane>>2))*DM+(wid>>2)*32+(lane&3)*8;
  const unsigned kdst=lds0+LDS_K+wid*1024, vdst=lds0+LDS_V+wid*1024;
  #define DMA_K(t,slot) glds16(ksrc+(long)(t)*KVBLK*DM,(unsigned)__builtin_amdgcn_readfirstlane(kdst+(slot)))
  #define DMA_V(t,slot) do{ glds16(vsrc+(long)(t)*KVBLK*DM,(unsigned)__builtin_amdgcn_readfirstlane(vdst+2*(slot))); glds16(vsrc+(long)(t)*KVBLK*DM+64,(unsigned)__builtin_amdgcn_readfirstlane(vdst+2*(slot)+8192)); }while(0)
  const int vb0=(int)(lds0+LDS_V)+((lane>>4)&1)*32+(lane&3)*8+(4*hi+((lane&15)>>2))*64;
  const char*Kbase=shm+LDS_K; bf16x8 kf[8];
  const lds_cptr shm3=(lds_cptr)shm; const lds_cptr kp0=shm3+LDS_K+hi*1024+r32*16; const lds_cptr vp0=shm3+LDS_V+((lane>>4)&1)*32+(lane&3)*8+(4*hi+((lane&15)>>2))*64;
  const int NT=(q0+QB)/KVBLK;
  DMA_K(0,0);DMA_V(0,0);DMA_K(1,SLOTB);
  bf16x8 qr[4];
  #pragma unroll
  for(int d0=0;d0<4;++d0)qr[d0]=*reinterpret_cast<const bf16x8*>(&Qw[(long)r32*DM+d0*16+hi*8]);
  float mhat=0.f,l_reg=0.f;f32x16 o[4];f32x16 negm; { float zz; asm volatile("v_mov_b32 %0, 0":"=v"(zz));
    _Pragma("unroll") for(int r=0;r<16;++r){o[0][r]=zz;o[1][r]=zz;o[2][r]=zz;o[3][r]=zz;negm[r]=zz;} } asm volatile("":"+v"(negm));
  const int qrel=wid*QBLK+r32;
  #define CMASK(P0,P1,t) do{int jb_=(t)-(NT-4); if(jb_>=0)cmask(P0,P1,jb_,qrel,hi);}while(0)
  bool resc=false;
  #define START(P0,P1) do{ const float rm=rowmax(P0,P1); resc=false; \
    { const float dl=rm; mhat=fadd_s(mhat,dl); \
      _Pragma("unroll") for(int r=0;r<16;++r){P0[r]=fsub_s(P0[r],dl);P1[r]=fsub_s(P1[r],dl);} \
      _Pragma("unroll") for(int r=0;r<16;++r)negm[r]=-mhat; asm volatile("":"+v"(negm)); } \
    _Pragma("unroll") for(int r=0;r<16;++r)P0[r]=__builtin_amdgcn_exp2f(P0[r]); }while(0)
  #define RESC() do{ if(resc){ asm volatile("s_waitcnt lgkmcnt(0)":::"memory"); \
      _Pragma("unroll") for(int d_=0;d_<4;++d_) _Pragma("unroll") for(int r=0;r<16;++r)o[d_][r]*=wsf[crow(r,hi)]; } }while(0)
  f32x16 pA0,pA1,pB0,pB1;
  int sl_prev=0,sl_cur=0,sl_next=SLOTB;
  #define ROT() do{sl_prev=sl_cur;sl_cur=sl_next;sl_next=(sl_next==(NSLOT-1)*SLOTB)?0:sl_next+SLOTB;}while(0)
  DMA_K(2,2*SLOTB);
  WAIT_BAR(3);
  qkt(pA0,pA1,Kbase,qr,negm,r32,hi);asm volatile("s_nop 15\n\ts_nop 7":"+v"(pA0),"+v"(pA1));CMASK(pA0,pA1,0);
  START(pA0,pA1);
  _Pragma("unroll") for(int r=0;r<16;++r)pA1[r]=__builtin_amdgcn_exp2f(pA1[r]);
  WAIT_BAR(0);
  DMA_K(3,0);DMA_V(1,SLOTB);
  ROT();
  kload8(kf,kp0+sl_cur);
  WAIT_BAR(3);
  s16x4 vlo[8],vhi[8]; u32x4 pw0,pw1,pw2,pw3;
  #define PKW(P,B) cvtpk_s(P[B],P[B+1])
  #define PAF(k) __builtin_bit_cast(bf16x8,pw##k)
  #define VFR(i) (bf16x8){vlo[i][0],vlo[i][1],vlo[i][2],vlo[i][3],vhi[i][0],vhi[i][1],vhi[i][2],vhi[i][3]}
  #define PIN(x) asm volatile("":"+v"(x))
  #define MX3(a,b,c) __builtin_fmaxf(__builtin_fmaxf((a),(b)),(c))
  #define GAPA(MF,A0,A1,A2,A3,W0,W1,PW) do{ MF; sacc+=A0; sacc+=A1; sacc+=A2; sacc+=A3; PIN(sacc); W0; W1; PIN(PW); SBAR(); }while(0)
  #define EX(v) __builtin_amdgcn_exp2f(v)
  #define GAPB(MF,R,X,B) do{ MF; R; X[B]=EX(X[B]); X[B+1]=EX(X[B+1]); PIN(X); SBAR(); }while(0)
  #define VRD2(i) do{ vlo[i]=vtr(vp_+((((i)>>2)+2)*4096+((i)&3)*1024)); vhi[i]=vtr(vp_+((((i)>>2)+2)*4096+((i)&3)*1024+512)); }while(0)
  #define VRD(i) do{ vlo[i]=vtr(vp_+(((i)>>2)*4096+((i)&3)*1024)); vhi[i]=vtr(vp_+(((i)>>2)*4096+((i)&3)*1024+512)); }while(0)
  #define KRD(G,j) do{ if(G){ kload2(kf,kp0+sl_next,j); SBAR(); } }while(0)
  #define STEP(C0,C1,P0,P1,t,GK,GV,GL) do{ SBAR(); \
    const lds_cptr vp_=vp0+2*sl_prev; \
    VRD(0); SBAR(); float sacc=(P0[0]+P0[1]); \
    GAPA(C0=__builtin_amdgcn_mfma_f32_32x32x16_bf16(kf[0],qr[0],negm,0,0,0), P0[2],P0[3],P0[4],P0[5],     pw0[0]=PKW(P0,0), pw0[1]=PKW(P0,2), pw0); \
    VRD(4); SBAR(); GAPA(C1=__builtin_amdgcn_mfma_f32_32x32x16_bf16(kf[1],qr[0],negm,0,0,0), P0[6],P0[7],P0[8],P0[9],     pw0[2]=PKW(P0,4), pw0[3]=PKW(P0,6), pw0); \
    VRD(1); SBAR(); GAPA(C0=__builtin_amdgcn_mfma_f32_32x32x16_bf16(kf[2],qr[1],C0,0,0,0),   P0[10],P0[11],P0[12],P0[13], pw1[0]=PKW(P0,8), pw1[1]=PKW(P0,10), pw1); \
    VRD(5); SBAR(); GAPA(C1=__builtin_amdgcn_mfma_f32_32x32x16_bf16(kf[3],qr[1],C1,0,0,0),   P0[14],P0[15],P1[0],P1[1],   pw1[2]=PKW(P0,12),pw1[3]=PKW(P0,14), pw1); \
    VRD(2); SBAR(); GAPA(C0=__builtin_amdgcn_mfma_f32_32x32x16_bf16(kf[4],qr[2],C0,0,0,0),   P1[2],P1[3],P1[4],P1[5],     pw2[0]=PKW(P1,0), pw2[1]=PKW(P1,2), pw2); \
    VRD(6); SBAR(); GAPA(C1=__builtin_amdgcn_mfma_f32_32x32x16_bf16(kf[5],qr[2],C1,0,0,0),   P1[6],P1[7],P1[8],P1[9],     pw2[2]=PKW(P1,4), pw2[3]=PKW(P1,6), pw2); \
    VRD(3); SBAR(); GAPA(C0=__builtin_amdgcn_mfma_f32_32x32x16_bf16(kf[6],qr[3],C0,0,0,0),   P1[10],P1[11],P1[12],P1[13], pw3[0]=PKW(P1,8), pw3[1]=PKW(P1,10), pw3); \
    VRD(7); SBAR(); GAPA(C1=__builtin_amdgcn_mfma_f32_32x32x16_bf16(kf[7],qr[3],C1,0,0,0),   P1[14],P1[15],0.f,0.f,       pw3[2]=PKW(P1,12),pw3[3]=PKW(P1,14), pw3); \
    l_reg+=sacc; \
    if(GK){DMA_K((t)+3,sl_cur);} if(GV){DMA_V((t)+1,sl_next);} \
    CMASK(C0,C1,t); \
    { float a=MX3(C0[0],C0[1],C1[0]),b=MX3(C0[2],C0[3],C1[1]); a=MX3(a,C1[2],C1[3]); \
      _Pragma("unroll") for(int r=4;r<16;r+=4){a=MX3(a,C0[r],C0[r+1]);b=MX3(b,C0[r+2],C0[r+3]);a=MX3(a,C1[r],C1[r+1]);b=MX3(b,C1[r+2],C1[r+3]);} \
      float rm=__builtin_fmaxf(a,b); { auto rr=__builtin_amdgcn_permlane32_swap(__float_as_uint(rm),__float_as_uint(rm),false,false); rm=__builtin_fmaxf(__uint_as_float(rr[0]),__uint_as_float(rr[1])); } \
      resc=false; \
      if(__builtin_expect(__any(rm>(float)THRL),0)){ const float dl=__builtin_fmaxf(rm,0.f); mhat+=dl; \
        _Pragma("unroll") for(int r=0;r<16;++r){C0[r]-=dl;C1[r]-=dl;} \
        _Pragma("unroll") for(int r=0;r<16;++r)negm[r]=-mhat; asm volatile("":"+v"(negm)); \
        const float f=__builtin_amdgcn_exp2f(-dl); l_reg*=f; if(hi==0)wsf[r32]=f; resc=true; } } \
    SBAR(); \
    GAPB(o[0]=__builtin_amdgcn_mfma_f32_32x32x16_bf16(PAF(0),VFR(0),o[0],0,0,0), VRD2(0), C0,0); \
    GAPB(o[1]=__builtin_amdgcn_mfma_f32_32x32x16_bf16(PAF(0),VFR(4),o[1],0,0,0), VRD2(4), C0,2); \
    KRD(GL,0); GAPB(o[0]=__builtin_amdgcn_mfma_f32_32x32x16_bf16(PAF(1),VFR(1),o[0],0,0,0), VRD2(1), C0,4); \
    KRD(GL,1); GAPB(o[1]=__builtin_amdgcn_mfma_f32_32x32x16_bf16(PAF(1),VFR(5),o[1],0,0,0), VRD2(5), C0,6); \
    KRD(GL,2); GAPB(o[0]=__builtin_amdgcn_mfma_f32_32x32x16_bf16(PAF(2),VFR(2),o[0],0,0,0), VRD2(2), C0,8); \
    KRD(GL,3); GAPB(o[1]=__builtin_amdgcn_mfma_f32_32x32x16_bf16(PAF(2),VFR(6),o[1],0,0,0), VRD2(6), C0,10); \
    GAPB(o[0]=__builtin_amdgcn_mfma_f32_32x32x16_bf16(PAF(3),VFR(3),o[0],0,0,0), VRD2(3), C0,12); \
    GAPB(o[1]=__builtin_amdgcn_mfma_f32_32x32x16_bf16(PAF(3),VFR(7),o[1],0,0,0), VRD2(7), C0,14); \
    GAPB(o[2]=__builtin_amdgcn_mfma_f32_32x32x16_bf16(PAF(0),VFR(0),o[2],0,0,0), (void)0, C1,0); \
    GAPB(o[3]=__builtin_amdgcn_mfma_f32_32x32x16_bf16(PAF(0),VFR(4),o[3],0,0,0), (void)0, C1,2); \
    GAPB(o[2]=__builtin_amdgcn_mfma_f32_32x32x16_bf16(PAF(1),VFR(1),o[2],0,0,0), (void)0, C1,4); \
    GAPB(o[3]=__builtin_amdgcn_mfma_f32_32x32x16_bf16(PAF(1),VFR(5),o[3],0,0,0), (void)0, C1,6); \
    GAPB(o[2]=__builtin_amdgcn_mfma_f32_32x32x16_bf16(PAF(2),VFR(2),o[2],0,0,0), (void)0, C1,8); \
    GAPB(o[3]=__builtin_amdgcn_mfma_f32_32x32x16_bf16(PAF(2),VFR(6),o[3],0,0,0), (void)0, C1,10); \
    GAPB(o[2]=__builtin_amdgcn_mfma_f32_32x32x16_bf16(PAF(3),VFR(3),o[2],0,0,0), (void)0, C1,12); \
    GAPB(o[3]=__builtin_amdgcn_mfma_f32_32x32x16_bf16(PAF(3),VFR(7),o[3],0,0,0), (void)0, C1,14); \
    }while(0)
  int t=1;
  #undef CMASK
  #define CMASK(P0,P1,t) do{}while(0)
  for(;t+5<NT;t+=2){
    STEP(pB0,pB1,pA0,pA1,t,true,true,true);     WAIT_BAR(3); RESC(); ROT();
    STEP(pA0,pA1,pB0,pB1,t+1,true,true,true);   WAIT_BAR(3); RESC(); ROT();
  }
  #undef CMASK
  #define CMASK(P0,P1,t) do{int jb_=(t)-(NT-4); if(jb_>=0)cmask(P0,P1,jb_,qrel,hi);}while(0)
  #define ENDW(tt) do{ if((tt)+3<NT){WAIT_BAR(3);} else if((tt)+2<NT){WAIT_BAR(2);} else {WAIT_BAR(0);} }while(0)
  for(;t+1<NT;t+=2){
    STEP(pB0,pB1,pA0,pA1,t,(t+3<NT),(t+1<NT),(t+1<NT));       ENDW(t);   RESC(); ROT();
    STEP(pA0,pA1,pB0,pB1,t+1,(t+4<NT),(t+2<NT),(t+2<NT));     ENDW(t+1); RESC(); ROT();
  }
  STEP(pB0,pB1,pA0,pA1,NT-1,false,false,false); RESC();
  { float sacc=pB0[0]+pB0[1]; _Pragma("unroll") for(int r=2;r<16;++r)sacc+=pB0[r]; _Pragma("unroll") for(int r=0;r<16;++r)sacc+=pB1[r]; l_reg+=sacc;
    pw0=(u32x4){PKW(pB0,0),PKW(pB0,2),PKW(pB0,4),PKW(pB0,6)};pw1=(u32x4){PKW(pB0,8),PKW(pB0,10),PKW(pB0,12),PKW(pB0,14)};pw2=(u32x4){PKW(pB1,0),PKW(pB1,2),PKW(pB1,4),PKW(pB1,6)};pw3=(u32x4){PKW(pB1,8),PKW(pB1,10),PKW(pB1,12),PKW(pB1,14)};
    SBAR(); pv(o,vb0+2*sl_cur,PAF(0),PAF(1),PAF(2),PAF(3)); }
  #undef PKW
  #undef PAF
  #undef VFR
  #undef PIN
  #undef MX3
  #undef GAPA
  #undef GAPB
  #undef EX
  #undef VRD
  #undef KRD
  #undef STEP
  #undef ENDW
  {auto rr=__builtin_amdgcn_permlane32_swap(__float_as_uint(l_reg),__float_as_uint(l_reg),false,false);l_reg=__uint_as_float(rr[0])+__uint_as_float(rr[1]);}
  if(hi==0)wsf[32+r32]=l_reg;asm volatile("s_waitcnt lgkmcnt(0)":::"memory");
  float rli[16];
  #pragma unroll
  for(int r=0;r<16;++r)rli[r]=__builtin_amdgcn_rcpf(wsf[32+crow(r,hi)]);
  bf16*Ow=O+(rowbase+q0+wid*QBLK)*OPITCH+ocol;
  { bf16*stg=(bf16*)(shm+LDS_OST)+wid*4096;
    #pragma unroll
    for(int r=0;r<16;++r){const int orow=crow(r,hi);
      #pragma unroll
      for(int d0=0;d0<4;++d0)stg[orow*128+d0*32+r32]=__float2bfloat16(o[d0][r]*rli[r]);}
    asm volatile("s_waitcnt lgkmcnt(0)":::"memory");
    if(!fuse){
      #pragma unroll
      for(int i=0;i<8;++i){const int row=i*4+(lane>>4),ch=lane&15; const u32x4 v=*(const u32x4*)(stg+row*128+ch*8); ATTN_STORE16(Ow+(long)row*OPITCH+ch*8,v);}
    } else {
      const int ch=lane&15; const bf16*O1w=Ow-128; bf16*OCw=OC+(rowbase+q0+wid*QBLK)*DM+occol;
      const float lamf=__uint_as_float(__builtin_amdgcn_readfirstlane(lamf_bits)), oscale=__uint_as_float(__builtin_amdgcn_readfirstlane(oscale_bits));
      asm volatile("s_waitcnt vmcnt(0)":::"memory");
      u32x4 a1[8];
      #pragma unroll
      for(int i=0;i<8;++i){const int row=i*4+(lane>>4); a1[i]=*(const u32x4*)(O1w+(long)row*OPITCH+ch*8);}
      const float4 gA=*(const float4*)(subln+ch*8), gB=*(const float4*)(subln+ch*8+4);
      #pragma unroll
      for(int i=0;i<8;++i){const int row=i*4+(lane>>4); const u32x4 v2=*(const u32x4*)(stg+row*128+ch*8); const u32x4 v1=a1[i];
        float x[8];
        x[0]=__uint_as_float(v1[0]<<16)-lamf*__uint_as_float(v2[0]<<16); x[1]=__uint_as_float(v1[0]&0xffff0000u)-lamf*__uint_as_float(v2[0]&0xffff0000u);
        x[2]=__uint_as_float(v1[1]<<16)-lamf*__uint_as_float(v2[1]<<16); x[3]=__uint_as_float(v1[1]&0xffff0000u)-lamf*__uint_as_float(v2[1]&0xffff0000u);
        x[4]=__uint_as_float(v1[2]<<16)-lamf*__uint_as_float(v2[2]<<16); x[5]=__uint_as_float(v1[2]&0xffff0000u)-lamf*__uint_as_float(v2[2]&0xffff0000u);
        x[6]=__uint_as_float(v1[3]<<16)-lamf*__uint_as_float(v2[3]<<16); x[7]=__uint_as_float(v1[3]&0xffff0000u)-lamf*__uint_as_float(v2[3]&0xffff0000u);
        float ss=(x[0]*x[0]+x[1]*x[1])+(x[2]*x[2]+x[3]*x[3])+(x[4]*x[4]+x[5]*x[5])+(x[6]*x[6]+x[7]*x[7]);
        ss+=__int_as_float(__builtin_amdgcn_update_dpp(0,__float_as_int(ss),0x128,0xf,0xf,false)); ss+=__int_as_float(__builtin_amdgcn_update_dpp(0,__float_as_int(ss),0x124,0xf,0xf,false));
        ss+=__int_as_float(__builtin_amdgcn_update_dpp(0,__float_as_int(ss),0x122,0xf,0xf,false)); ss+=__int_as_float(__builtin_amdgcn_update_dpp(0,__float_as_int(ss),0x121,0xf,0xf,false));
        const float rs=__builtin_amdgcn_rsqf(ss*(1.0f/128.0f)+1e-5f)*oscale;
        u32x4 w; w[0]=cvtpk_s(x[0]*gA.x*rs,x[1]*gA.y*rs); w[1]=cvtpk_s(x[2]*gA.z*rs,x[3]*gA.w*rs); w[2]=cvtpk_s(x[4]*gB.x*rs,x[5]*gB.y*rs); w[3]=cvtpk_s(x[6]*gB.z*rs,x[7]*gB.w*rs);
        *(u32x4*)(OCw+(long)row*DM+ch*8)=w; }
    } }
  asm volatile("s_waitcnt lgkmcnt(0)\n\ts_barrier":::"memory");
  #undef DMA_K
  #undef DMA_V
  #undef CMASK
  #undef START
  #undef RESC
  #undef ROT
}
constexpr int ATTN_LDS_BYTES=LDS_BYTES;
#undef SBAR
#undef WAIT_BAR
}
#ifndef STAGGER_ON
#define STAGGER_ON 0
#endif
#ifndef STAGGER_OUT
#define STAGGER_OUT 600
#endif
#ifndef STAGGER_DOWN
#define STAGGER_DOWN 1400
#endif
#ifndef PG8_ALIGN_EPI
#define PG8_ALIGN_EPI true
#endif
#ifndef PG8_SP2
#define PG8_SP2 true
#endif
namespace cg = cooperative_groups;
constexpr int NWAVES = 8;
constexpr int BATCH = 32, SEQ = 2048, D = 1024, M = BATCH * SEQ, DFF = 2816, GW = 1536;
constexpr size_t MiB = 1u << 20;
constexpr size_t WS_W_ATT_IN = 1 * MiB, WS_W_ATT_OUT = 13 * MiB, WS_W_G_IN = 17 * MiB, WS_W_G_OUT = 23 * MiB, WS_W_C_IN = 26 * MiB, WS_W_C_OUT = 32 * MiB, WS_W_GU = 34 * MiB, WS_W_DN = 78 * MiB, WS_WSB = 100 * MiB;
constexpr size_t WS_ROPE = 101 * MiB, WS_SSQ = 117 * MiB, WS_VSTAT = 121 * MiB, WS_XB = 133 * MiB, WS_ARENA = 261 * MiB, WS_END = 901 * MiB;
constexpr size_t AR_Q = 0, AR_K = 128 * MiB, AR_V = 256 * MiB, AR_O = 384 * MiB;
constexpr size_t AR_U = 0, AR_GV = 192 * MiB, AR_UV = 384 * MiB;
constexpr size_t AR_GB = 0, AR_HC = 128 * MiB, AR_Y = 256 * MiB;
constexpr size_t AR_H = 0;
constexpr int LDS_BYTES = 147456;

#define GAS __attribute__((address_space(1)))
#define LAS __attribute__((address_space(3)))
typedef unsigned short bf16;
typedef unsigned v4u __attribute__((ext_vector_type(4)));
typedef unsigned v2u __attribute__((ext_vector_type(2)));
typedef float f32x4 __attribute__((ext_vector_type(4)));
typedef float f32x2 __attribute__((ext_vector_type(2)));
typedef short bf16x8 __attribute__((ext_vector_type(8)));
typedef short s16x4 __attribute__((ext_vector_type(4)));
#define LDS_WAIT() asm volatile("s_waitcnt lgkmcnt(0)" ::: "memory")
#define VM_WAIT() asm volatile("s_waitcnt vmcnt(0)" ::: "memory")
__device__ __forceinline__ unsigned f2bf(float f) { unsigned u = __builtin_bit_cast(unsigned, f); return (u + 0x7fffu + ((u >> 16) & 1u)) >> 16; }
__device__ __forceinline__ unsigned pk2(float lo, float hi) { return f2bf(lo) | (f2bf(hi) << 16); }
__device__ __forceinline__ float bflo(unsigned w) { return __uint_as_float(w << 16); }
__device__ __forceinline__ float bfhi(unsigned w) { return __uint_as_float(w & 0xffff0000u); }
__device__ __forceinline__ float wave_sum(float v) {
    v += __int_as_float(__builtin_amdgcn_update_dpp(0, __float_as_int(v), 0x128, 0xf, 0xf, false)); v += __int_as_float(__builtin_amdgcn_update_dpp(0, __float_as_int(v), 0x124, 0xf, 0xf, false));
    v += __int_as_float(__builtin_amdgcn_update_dpp(0, __float_as_int(v), 0x122, 0xf, 0xf, false)); v += __int_as_float(__builtin_amdgcn_update_dpp(0, __float_as_int(v), 0x121, 0xf, 0xf, false));
    { const auto a = __builtin_amdgcn_permlane16_swap(__float_as_uint(v), __float_as_uint(v), false, false); v = __uint_as_float(a[0]) + __uint_as_float(a[1]); }
    { const auto b = __builtin_amdgcn_permlane32_swap(__float_as_uint(v), __float_as_uint(v), false, false); v = __uint_as_float(b[0]) + __uint_as_float(b[1]); }
    return v;
}

struct Params { const void* in[21]; float* out; unsigned char* ws; float lam0, lam1; };

__device__ __forceinline__ void p0_item(const float* W, int K, int N, bf16* WT, const float* gain, int kind, LAS float* scr, int item, int lane) {
    const int nblk = N / 32, kb = item / nblk, nb = item % nblk, k0 = 64 * kb, n0 = 32 * nb;
    int d0 = n0;
    if (kind == 1) { if (n0 < 2048) { const int part = n0 >> 10, head = (n0 >> 6) & 15, half = (n0 >> 5) & 1; d0 = (part * 4 + (head >> 2)) * 256 + half * 128 + (head & 3) * 32; } }
    else if (kind == 2) { if (n0 < 2816) d0 = (n0 >> 7) * 256 + (n0 & 127); else { const int j = n0 - 2816; d0 = (j >> 7) * 256 + 128 + (j & 127); } }
    else if (kind == 3) { if (n0 >= 2048) { const int j = n0 - 2048; d0 = 1024 + (j >> 7) * 256 + 128 + (j & 127); } else if (n0 >= 1024) { const int j = n0 - 1024; d0 = 1024 + (j >> 7) * 256 + (j & 127); } }
    f32x4 wv[8];
#pragma unroll
    for (int i = 0; i < 8; ++i) { const int kk = 8 * i + (lane >> 3); wv[i] = *(const f32x4*)(W + (size_t)(k0 + kk) * N + n0 + (lane & 7) * 4); }
#pragma unroll
    for (int i = 0; i < 8; ++i) { const int kk = 8 * i + (lane >> 3); const float gk = gain ? gain[k0 + kk] : 1.0f; LAS float* d = scr + kk * 33 + (lane & 7) * 4;
        d[0] = wv[i][0] * gk; d[1] = wv[i][1] * gk; d[2] = wv[i][2] * gk; d[3] = wv[i][3] * gk; }
    LDS_WAIT(); asm volatile("" ::: "memory");
    const int c = lane & 7;
#pragma unroll
    for (int j = 0; j < 4; ++j) { const int n = (lane >> 3) + 8 * j; const LAS float* s = scr + (8 * c) * 33 + n;
        v4u o; o.x = pk2(s[0 * 33], s[1 * 33]); o.y = pk2(s[2 * 33], s[3 * 33]); o.z = pk2(s[4 * 33], s[5 * 33]); o.w = pk2(s[6 * 33], s[7 * 33]);
        *(v4u*)(WT + (size_t)(d0 + n) * K + k0 + 8 * c) = o; }
    LDS_WAIT(); asm volatile("" ::: "memory");
}

typedef const __attribute__((address_space(4))) unsigned char* kaptr_t;
#define KIN(k) ((const float*)(const float __attribute__((address_space(1)))*)(*(const unsigned long long __attribute__((address_space(4)))*)(ka + 8 * (k))))
#define KOUT ((float*)(float __attribute__((address_space(1)))*)(*(const unsigned long long __attribute__((address_space(4)))*)(ka + 168)))
#define KWS ((unsigned char*)(unsigned char __attribute__((address_space(1)))*)(*(const unsigned long long __attribute__((address_space(4)))*)(ka + 176)))
#define KLAM(jj) (*(const float __attribute__((address_space(4)))*)(ka + 184 + 4 * (jj)))
#define LAUNDER() do { asm volatile("" : "+s"(ka)); asm volatile("" : "+v"(tid)); tid &= 511; } while (0)
#define WSPTRS() unsigned char* const ws = KWS; bf16* const XB = (bf16*)(ws + WS_XB); float* const SSQ = (float*)(ws + WS_SSQ); unsigned char* const AR = ws + WS_ARENA; (void)XB; (void)SSQ; (void)AR

#define XB_TMO      128
#define XB_XCNT(j)  (256  + 64 * (j))
#define XB_XSUB(j)  (1280 + 64 * (j))
#define XB_XGEN(j)  (2304 + 64 * (j))
#define XB_TOP      3328
#define XB_TOPGEN   3392
#define XCD_BAR_WORDS 3456
#define XB_SPIN_CAP (1u << 18)

__device__ __forceinline__ unsigned xb_ld(unsigned* p)              { return __hip_atomic_load(p, __ATOMIC_RELAXED, __HIP_MEMORY_SCOPE_AGENT); }
__device__ __forceinline__ unsigned xb_add(unsigned* p, unsigned v) { return __hip_atomic_fetch_add(p, v, __ATOMIC_RELAXED, __HIP_MEMORY_SCOPE_AGENT); }
__device__ __forceinline__ unsigned xb_xcc_id() { return (unsigned)__builtin_amdgcn_s_getreg((3 << 11) | 20) & 0xFu; }
#define XB_SPIN(cond, bar) do { unsigned _sp = 0; while (cond) { __builtin_amdgcn_s_sleep(1); \
    if ((++_sp & 255u) == 0u) { if (xb_ld(&(bar)[XB_TMO])) break; if (_sp > XB_SPIN_CAP) { atomicAdd(&(bar)[XB_TMO], 1u); break; } } } } while (0)

struct XcdBarrier {
    unsigned* bar; unsigned x;
    volatile LAS unsigned* st;
};

__device__ __forceinline__ XcdBarrier xcd_barrier_post(unsigned* bar, volatile LAS unsigned* st) {
    XcdBarrier b; b.bar = bar; b.x = xb_xcc_id(); b.st = st;
    if (threadIdx.x == 0) (void)xb_add(&bar[XB_XCNT(b.x)], 1u);
    return b;
}
__device__ __forceinline__ void xcd_barrier_complete(unsigned* bar, unsigned x, unsigned& nloc, unsigned& nx) {
    const unsigned G = gridDim.x * gridDim.y * gridDim.z;
    unsigned sum, cnt, mine, sp = 0u;
    for (;;) {
        sum = 0u; cnt = 0u; mine = 0u;
#pragma unroll
        for (unsigned j = 0; j < 16; ++j) { const unsigned c = xb_ld(&bar[XB_XCNT(j)]); sum += c; cnt += (c > 0u) ? 1u : 0u; mine = (j == x) ? c : mine; }
        if (sum == G) break;
        __builtin_amdgcn_s_sleep(1);
        if ((++sp & 255u) == 0u) { if (xb_ld(&bar[XB_TMO])) break; if (sp > XB_SPIN_CAP) { atomicAdd(&bar[XB_TMO], 1u); break; } }
    }
    nloc = mine > 0u ? mine : 1u; nx = cnt > 0u ? cnt : 1u;
}

__device__ __forceinline__ void xcd_barrier(const XcdBarrier& b) {
    asm volatile("s_waitcnt vmcnt(0)" ::: "memory");
    __syncthreads();
    if (threadIdx.x == 0) {
        unsigned* bar = b.bar;
        __builtin_amdgcn_s_waitcnt(0);
        unsigned nloc = b.st[0], nx = b.st[1];
        if (nloc == 0u) { xcd_barrier_complete(bar, b.x, nloc, nx); b.st[0] = nloc; b.st[1] = nx; }
        const unsigned old = xb_add(&bar[XB_XSUB(b.x)], 1u);
        const unsigned gen = old / nloc;
        if (old + 1u == (gen + 1u) * nloc) {
            __builtin_amdgcn_fence(__ATOMIC_RELEASE, "agent");
            asm volatile("s_waitcnt vmcnt(0)" ::: "memory");
            const unsigned og = xb_add(&bar[XB_TOP], 1u);
            const unsigned tg = og / nx;
            if (og + 1u == (tg + 1u) * nx) xb_add(&bar[XB_TOPGEN], 1u);
            else XB_SPIN(xb_ld(&bar[XB_TOPGEN]) == tg, bar);
            __builtin_amdgcn_fence(__ATOMIC_ACQUIRE, "agent");
            xb_add(&bar[XB_XGEN(b.x)], 1u);
            asm volatile("s_waitcnt vmcnt(0)" ::: "memory");
        } else {
            XB_SPIN(xb_ld(&bar[XB_XGEN(b.x)]) == gen, bar);
            __builtin_amdgcn_fence(__ATOMIC_ACQUIRE, "agent");
            asm volatile("s_waitcnt vmcnt(0)" ::: "memory");
        }
    }
    __syncthreads();
}

__device__ __forceinline__ void light_step(const int step, kaptr_t& ka, int& tid, LAS unsigned char* const L, const int G, const int bx, const int vcu) {
        const int layer = step / 5, stage = step % 5, kind = layer % 3, j = layer / 3;
        LAUNDER(); WSPTRS();
        const int lane = tid & 63, wave = __builtin_amdgcn_readfirstlane(tid >> 6); (void)lane; (void)wave;
        if (stage != 1) {
            pg8::Gemm g; pg8::EpiGen E;
            float* const out = KOUT;
            g.M = M; E.ssq = SSQ; E.eps = 1e-6f; E.o0 = nullptr; E.o1 = nullptr; E.o2 = nullptr; E.pos = (const int*)KIN(1); E.bias = KIN(10); E.vstat = (pg8::f32x2e*)(ws + WS_VSTAT); E.xout = nullptr; E.xb = XB;
            if (stage == 0) {
                g.A = XB; g.K = 1024; g.N = 3072;
                if (kind == 0) { g.Bt = (const bf16*)(ws + WS_W_ATT_IN) + (size_t)j * 3145728; E.mode = 0; E.o0 = (bf16*)(AR + AR_Q); E.o1 = (bf16*)(AR + AR_K); E.o2 = (bf16*)(AR + AR_V); }
                else if (kind == 1) { g.Bt = (const bf16*)(ws + WS_W_G_IN); E.mode = 1; E.o0 = (bf16*)(AR + AR_U); E.o1 = (bf16*)(AR + AR_GV); }
                else { g.Bt = (const bf16*)(ws + WS_W_C_IN); E.mode = 2; E.o0 = (bf16*)(AR + AR_GB); E.o1 = (bf16*)(AR + AR_HC); }
            } else if (stage == 2) {
                g.N = 1024; E.mode = 3; E.o0 = XB;
                if (kind == 0) { g.A = (const bf16*)(AR + AR_Q); g.Bt = (const bf16*)(ws + WS_W_ATT_OUT) + (size_t)j * 1048576; g.K = 1024; }
                else if (kind == 1) { g.A = (const bf16*)(AR + AR_UV); g.Bt = (const bf16*)(ws + WS_W_G_OUT); g.K = 1536; }
                else { g.A = (const bf16*)(AR + AR_Y); g.Bt = (const bf16*)(ws + WS_W_C_OUT); g.K = 1024; }
            } else if (stage == 3) {
                g.A = XB; g.Bt = (const bf16*)(ws + WS_W_GU) + (size_t)layer * 5767168; g.N = 5632; g.K = 1024; E.mode = 4; E.o0 = (bf16*)(AR + AR_H);
            } else {
                g.A = (const bf16*)(AR + AR_H); g.Bt = (const bf16*)(ws + WS_W_DN) + (size_t)layer * 2883584; g.N = 1024; g.K = 2816; E.mode = 3; E.o0 = (layer == 3) ? nullptr : XB; E.xout = (layer == 3) ? out : nullptr;
            }
            pg8::StaticOrder S; S.init(g.M, g.N, G, bx);
            if (E.mode == 3 && STAGGER_ON) {
                const unsigned long long dl = (unsigned long long)(bx >> 6) * (stage == 2 ? STAGGER_OUT : STAGGER_DOWN);
                const unsigned long long t0_ = __builtin_amdgcn_s_memrealtime(); while (__builtin_amdgcn_s_memrealtime() - t0_ < dl) __builtin_amdgcn_s_sleep(4);
            }
            pg8::gemm_phase<pg8::EpiGen, pg8::StaticOrder, PG8_ALIGN_EPI, PG8_SP2>(L, g, S, E, tid);
        } else if (kind == 1) {
            const bf16* U = (const bf16*)(AR + AR_U); const bf16* GV = (const bf16*)(AR + AR_GV); bf16* UV = (bf16*)(AR + AR_UV);
            constexpr int SP_RS = 784;
            LAS f32x2* stat = (LAS f32x2*)(L + 128 * SP_RS); const f32x2* VSTAT = (const f32x2*)(ws + WS_VSTAT); const bf16* WSB = (const bf16*)(ws + WS_WSB);
            const float* gmlp_ln_g = KIN(11); const float* gmlp_ln_b = KIN(12); const float* gmlp_b_s = KIN(14);
            const int fr = lane & 15, fq = lane >> 4;
            const int cgp = tid % 48, rsl = tid / 48;
            for (int unit = vcu; unit < 2048; unit += G) {
                const int chunk = unit >> 2, gp = unit & 3; const size_t row0 = (size_t)chunk * 128;
                const int c = gp * 384 + cgp * 8;
                const f32x4 ga = *(const f32x4*)(gmlp_ln_g + c), gb = *(const f32x4*)(gmlp_ln_g + c + 4), ba = *(const f32x4*)(gmlp_ln_b + c), bb = *(const f32x4*)(gmlp_ln_b + c + 4);
                bf16x8 wsf[2][4];
#pragma unroll
                for (int gi = 0; gi < 2; ++gi)
#pragma unroll
                    for (int kk = 0; kk < 4; ++kk) wsf[gi][kk] = *(const bf16x8*)(WSB + ((size_t)(2 * gp + gi) * 128 + 16 * wave + fr) * 128 + 32 * kk + 8 * fq);
                __syncthreads();
                if (tid < 128) {
                    const f32x4* ps = (const f32x4*)(VSTAT + (row0 + tid) * 24); float s1 = 0.f, s2 = 0.f;
#pragma unroll
                    for (int i = 0; i < 12; ++i) { const f32x4 q = ps[i]; s1 += q[0] + q[2]; s2 += q[1] + q[3]; }
                    const float mean = s1 * (1.0f / 1536.0f); const float var = fmaxf(s2 * (1.0f / 1536.0f) - mean * mean, 0.f);
                    stat[tid] = (f32x2){mean, __builtin_amdgcn_rsqf(var + 1e-5f)};
                }
                v4u raw[13];
#pragma unroll
                for (int i = 0; i < 13; ++i) { const int r = rsl + 10 * i; raw[i] = *(const v4u*)(GV + (row0 + (r < 128 ? r : 127)) * 1536 + c); }
                __syncthreads();
#pragma unroll
                for (int i = 0; i < 13; ++i) {
                    const int r = rsl + 10 * i;
                    if (tid < 480 && r < 128) {
                        const f32x2 st = stat[r];
                        f32x4 v0 = (f32x4){bflo(raw[i].x), bfhi(raw[i].x), bflo(raw[i].y), bfhi(raw[i].y)}, v1 = (f32x4){bflo(raw[i].z), bfhi(raw[i].z), bflo(raw[i].w), bfhi(raw[i].w)};
                        v0 = (v0 - st.x) * st.y * ga + ba; v1 = (v1 - st.x) * st.y * gb + bb;
                        *(LAS v4u*)(L + r * SP_RS + cgp * 16) = (v4u){pk2(v0[0], v0[1]), pk2(v0[2], v0[3]), pk2(v1[0], v1[1]), pk2(v1[2], v1[3])};
                    }
                }
                __syncthreads();
                const int t = 16 * wave + fr; const int nk = (wave >> 1) + 1;
                v2u uv_[2][12];
#pragma unroll
                for (int gi = 0; gi < 2; ++gi)
#pragma unroll
                    for (int n = 0; n < 12; ++n) uv_[gi][n] = *(const v2u*)(U + (row0 + t) * 1536 + (2 * gp + gi) * 192 + 16 * n + 4 * fq);
#pragma unroll
                for (int gi = 0; gi < 2; ++gi) {
                    const int gg = 2 * gp + gi;
                    f32x4 acc[12];
#pragma unroll
                    for (int n = 0; n < 12; ++n) acc[n] = (f32x4){0.f, 0.f, 0.f, 0.f};
#pragma unroll
                    for (int kk = 0; kk < 4; ++kk) {
                        if (kk < nk) {
                            const LAS unsigned char* tb = L + (32 * kk + 8 * fq + ((lane >> 2) & 3)) * SP_RS + gi * 384 + (lane & 3) * 8;
#pragma unroll
                            for (int n = 0; n < 12; ++n) {
                                const s16x4 lo = __builtin_bit_cast(s16x4, __builtin_amdgcn_ds_read_tr16_b64_v4i16((LAS s16x4*)(tb + n * 32)));
                                const s16x4 hi = __builtin_bit_cast(s16x4, __builtin_amdgcn_ds_read_tr16_b64_v4i16((LAS s16x4*)(tb + n * 32 + 4 * SP_RS)));
                                const bf16x8 vf = (bf16x8){lo[0], lo[1], lo[2], lo[3], hi[0], hi[1], hi[2], hi[3]};
                                acc[n] = __builtin_amdgcn_mfma_f32_16x16x32_bf16(vf, wsf[gi][kk], acc[n], 0, 0, 0);
                            }
                        }
                    }
                    const float bs = gmlp_b_s[gg * 128 + t];
#pragma unroll
                    for (int n = 0; n < 12; ++n) {
                        const size_t o = (row0 + t) * 1536 + gg * 192 + 16 * n + 4 * fq;
                        const v2u uu = uv_[gi][n];
                        const f32x4 sv = acc[n] + bs;
                        *(v2u*)(UV + o) = (v2u){pk2(bflo(uu.x) * sv[0], bfhi(uu.x) * sv[1]), pk2(bflo(uu.y) * sv[2], bfhi(uu.y) * sv[3])};
                    }
                }
            }
        } else {
            const float* conv_w = KIN(17);
            const bf16* GBp = (const bf16*)(AR + AR_GB); const bf16* HC = (const bf16*)(AR + AR_HC); bf16* Y = (bf16*)(AR + AR_Y);
            const int gt = vcu * (NWAVES * 64) + tid, NGT = G * NWAVES * 64;
            for (int it = gt; it < (M / 8) * 128; it += NGT) {
                const int cgp = it & 127, rb = it >> 7, c = cgp * 8; const size_t t0 = (size_t)rb * 8;
                const f32x4 w0a = *(const f32x4*)(conv_w + c), w0b = *(const f32x4*)(conv_w + c + 4), w1a = *(const f32x4*)(conv_w + 1024 + c), w1b = *(const f32x4*)(conv_w + 1024 + c + 4), w2a = *(const f32x4*)(conv_w + 2048 + c), w2b = *(const f32x4*)(conv_w + 2048 + c + 4);
                f32x4 m2a = (f32x4){0.f, 0.f, 0.f, 0.f}, m2b = m2a, m1a = m2a, m1b = m2a;
                if ((t0 & (SEQ - 1)) != 0) {
                    const v4u r2 = *(const v4u*)(HC + (t0 - 2) * 1024 + c), r1 = *(const v4u*)(HC + (t0 - 1) * 1024 + c);
                    m2a = (f32x4){bflo(r2.x), bfhi(r2.x), bflo(r2.y), bfhi(r2.y)}; m2b = (f32x4){bflo(r2.z), bfhi(r2.z), bflo(r2.w), bfhi(r2.w)};
                    m1a = (f32x4){bflo(r1.x), bfhi(r1.x), bflo(r1.y), bfhi(r1.y)}; m1b = (f32x4){bflo(r1.z), bfhi(r1.z), bflo(r1.w), bfhi(r1.w)};
                }
                v4u hrv[8], grv[8];
#pragma unroll
                for (int r = 0; r < 8; ++r) { hrv[r] = *(const v4u*)(HC + (t0 + r) * 1024 + c); grv[r] = *(const v4u*)(GBp + (t0 + r) * 1024 + c); }
#pragma unroll
                for (int r = 0; r < 8; ++r) {
                    const v4u hr = hrv[r], gr = grv[r];
                    const f32x4 ha = (f32x4){bflo(hr.x), bfhi(hr.x), bflo(hr.y), bfhi(hr.y)}, hb = (f32x4){bflo(hr.z), bfhi(hr.z), bflo(hr.w), bfhi(hr.w)};
                    const f32x4 ga = (f32x4){bflo(gr.x), bfhi(gr.x), bflo(gr.y), bfhi(gr.y)}, gb = (f32x4){bflo(gr.z), bfhi(gr.z), bflo(gr.w), bfhi(gr.w)};
                    const f32x4 ya = ga * (w0a * m2a + w1a * m1a + w2a * ha), yb = gb * (w0b * m2b + w1b * m1b + w2b * hb);
                    *(v4u*)(Y + (t0 + r) * 1024 + c) = (v4u){pk2(ya[0], ya[1]), pk2(ya[2], ya[3]), pk2(yb[0], yb[1]), pk2(yb[2], yb[3])};
                    m2a = m1a; m2b = m1b; m1a = ha; m1b = hb;
                }
            }
        }
}

__device__ __forceinline__ void attn_step(const int j, kaptr_t& ka, int& tid, char* const ldsg, const int G, const int vcu) {
        LAUNDER(); WSPTRS();
        {
            const attn_body::bf16* Q = (const attn_body::bf16*)(AR + AR_Q); const attn_body::bf16* Kp = (const attn_body::bf16*)(AR + AR_K); const attn_body::bf16* Vp = (const attn_body::bf16*)(AR + AR_V);
            attn_body::bf16* O = (attn_body::bf16*)(AR + AR_O);
            const float lam_init = KLAM(j); const float* attn_lambda = KIN(6); const float* attn_subln = KIN(7);
            const float* lam = attn_lambda + j * 256; const int lane0 = tid & 63;
            const float la = wave_sum(lam[lane0] * lam[64 + lane0]), lb = wave_sum(lam[128 + lane0] * lam[192 + lane0]);
            const unsigned lamf_bits = __builtin_amdgcn_readfirstlane(__float_as_uint(__expf(la) - __expf(lb) + lam_init)), oscale_bits = __builtin_amdgcn_readfirstlane(__float_as_uint(1.0f - lam_init));
            for (int bh = vcu; bh < BATCH * 8; bh += G) {
                const int b = bh >> 3, h = bh & 7;
                for (int ui = 0; ui < 16; ++ui) {
                    const int qb = 7 - (ui >> 1), map = ui & 1;
                    attn_body::attn_unit<8>(b, 2 * h + map, h * 128, h * 256 + map * 128, qb, Q, Kp, Vp, O, ldsg, tid, map == 1, lamf_bits, oscale_bits, attn_subln + j * 128, (attn_body::bf16*)(AR + AR_Q), h * 128);
                }
            }
        }
}

#ifndef PROBE_MASK
#define PROBE_MASK 0u
#endif
__global__ void __launch_bounds__(NWAVES * 64, 2) trunk_fwd(Params p) {
    extern __shared__ __attribute__((aligned(16))) unsigned char lds[];
    cg::grid_group grid = cg::this_grid();
    LAS unsigned char* const L = (LAS unsigned char*)lds;
    const int G = gridDim.x; const int bx = blockIdx.x; const int vcu = (G % 8 == 0) ? (bx % 8) * (G / 8) + bx / 8 : bx;
    kaptr_t ka = (kaptr_t)__builtin_amdgcn_kernarg_segment_ptr();
    int tid = threadIdx.x;

#if PROBE_MASK
    unsigned long long* const TS = (unsigned long long*)KWS;
#define STAMP(k) do { if (blockIdx.x == 0 && threadIdx.x == 0) TS[(k)] = __builtin_amdgcn_s_memrealtime(); } while (0)
#else
#define STAMP(k) do { } while (0)
#endif
    STAMP(0);
#ifdef PROBE_DELAY
    { const unsigned long long t0_ = __builtin_amdgcn_s_memrealtime(); while (__builtin_amdgcn_s_memrealtime() - t0_ < (unsigned long long)PROBE_DELAY) __builtin_amdgcn_s_sleep(8); }
#endif
    {
        LAUNDER(); WSPTRS();
        const int lane = tid & 63, wave = __builtin_amdgcn_readfirstlane(tid >> 6);
        const float* x_in = KIN(0); const float* mix_norm = KIN(2); const float* ffn_norm = KIN(3);
        const float* attn_w_in = KIN(5); const float* attn_w_out = KIN(8); const float* gmlp_w_in = KIN(9); const float* gmlp_w_s = KIN(13); const float* gmlp_w_out = KIN(15);
        const float* conv_w_in = KIN(16); const float* conv_w_out = KIN(18); const float* ffn_w_gu = KIN(19); const float* ffn_w_dn = KIN(20);
        bf16* const W_ATT_IN = (bf16*)(ws + WS_W_ATT_IN); bf16* const W_ATT_OUT = (bf16*)(ws + WS_W_ATT_OUT); bf16* const W_G_IN = (bf16*)(ws + WS_W_G_IN); bf16* const W_G_OUT = (bf16*)(ws + WS_W_G_OUT);
        bf16* const W_C_IN = (bf16*)(ws + WS_W_C_IN); bf16* const W_C_OUT = (bf16*)(ws + WS_W_C_OUT); bf16* const W_GU = (bf16*)(ws + WS_W_GU); bf16* const W_DN = (bf16*)(ws + WS_W_DN); bf16* const WSB = (bf16*)(ws + WS_WSB);
        LAS float* scr = (LAS float*)(L + wave * 16384);
        const int gw = vcu * NWAVES + wave, NGW = G * NWAVES;
        constexpr int I_AIN = 16 * 96, I_AOUT = 16 * 32, I_GOUT = 24 * 32, I_GU = 16 * 176, I_DN = 44 * 32;
        constexpr int NITEMS = 2 * I_AIN + 2 * I_AOUT + I_AIN + I_GOUT + I_AIN + I_AOUT + 4 * I_GU + 4 * I_DN;
        for (int it = gw; it < NITEMS; it += NGW) {
            int r = it;
            if (r < 2 * I_AIN) { const int j = r / I_AIN; p0_item(attn_w_in + (size_t)j * 3145728, 1024, 3072, W_ATT_IN + (size_t)j * 3145728, mix_norm + (j ? 3 : 0) * 1024, 1, scr, r % I_AIN, lane); continue; } r -= 2 * I_AIN;
            if (r < 2 * I_AOUT) { const int j = r / I_AOUT; p0_item(attn_w_out + (size_t)j * 1048576, 1024, 1024, W_ATT_OUT + (size_t)j * 1048576, nullptr, 0, scr, r % I_AOUT, lane); continue; } r -= 2 * I_AOUT;
            if (r < I_AIN) { p0_item(gmlp_w_in, 1024, 3072, W_G_IN, mix_norm + 1024, 0, scr, r, lane); continue; } r -= I_AIN;
            if (r < I_GOUT) { p0_item(gmlp_w_out, 1536, 1024, W_G_OUT, nullptr, 0, scr, r, lane); continue; } r -= I_GOUT;
            if (r < I_AIN) { p0_item(conv_w_in, 1024, 3072, W_C_IN, mix_norm + 2048, 3, scr, r, lane); continue; } r -= I_AIN;
            if (r < I_AOUT) { p0_item(conv_w_out, 1024, 1024, W_C_OUT, nullptr, 0, scr, r, lane); continue; } r -= I_AOUT;
            if (r < 4 * I_GU) { const int j = r / I_GU; p0_item(ffn_w_gu + (size_t)j * 5767168, 1024, 5632, W_GU + (size_t)j * 5767168, ffn_norm + j * 1024, 2, scr, r % I_GU, lane); continue; } r -= 4 * I_GU;
            { const int j = r / I_DN; p0_item(ffn_w_dn + (size_t)j * 2883584, 2816, 1024, W_DN + (size_t)j * 2883584, nullptr, 0, scr, r % I_DN, lane); }
        }
        const int gt = vcu * (NWAVES * 64) + tid, NGT = G * NWAVES * 64;
        for (int i = gt; i < 8 * 128 * 128; i += NGT) { const int s = i & 127, t = (i >> 7) & 127; WSB[i] = (s <= t) ? (bf16)f2bf(gmlp_w_s[i]) : (bf16)0; }
        for (int m0 = gw * 4; m0 < M; m0 += NGW * 4) {
            f32x4 v[4][4]; float s[4];
#pragma unroll
            for (int r = 0; r < 4; ++r) { const f32x4* xr = (const f32x4*)(x_in + (size_t)(m0 + r) * D) + lane;
#pragma unroll
                for (int j = 0; j < 4; ++j) v[r][j] = xr[64 * j]; }
#pragma unroll
            for (int r = 0; r < 4; ++r) { float a = 0.f;
#pragma unroll
                for (int j = 0; j < 4; ++j) a += (v[r][j][0] * v[r][j][0] + v[r][j][1] * v[r][j][1]) + (v[r][j][2] * v[r][j][2] + v[r][j][3] * v[r][j][3]);
                s[r] = wave_sum(a);
                v2u* o8 = (v2u*)(XB + (size_t)(m0 + r) * D) + lane;
#pragma unroll
                for (int j = 0; j < 4; ++j) o8[64 * j] = (v2u){pk2(v[r][j][0], v[r][j][1]), pk2(v[r][j][2], v[r][j][3])};
                if (lane < 16) SSQ[(size_t)(m0 + r) * 16 + lane] = (lane == 0) ? s[r] : 0.f; }
        }
    }
    unsigned* const barw = (unsigned*)(KWS + 65536);
    if (blockIdx.x == 0) for (int i_ = threadIdx.x; i_ < XCD_BAR_WORDS; i_ += NWAVES * 64) barw[i_] = 0u;
    volatile LAS unsigned* const bst = (volatile LAS unsigned*)(L + LDS_BYTES - 16);
    if (threadIdx.x < 2) bst[threadIdx.x] = 0u;
    grid.sync(); STAMP(1);
    (void)xcd_barrier_post(barw, bst);
#define GSYNC() do { XcdBarrier b_; b_.bar = (unsigned*)(KWS + 65536); b_.x = xb_xcc_id(); b_.st = (volatile LAS unsigned*)(L + LDS_BYTES - 16); xcd_barrier(b_); } while (0)
#ifdef PROBE_NSYNC
    for (int i_ = 0; i_ < PROBE_NSYNC; ++i_) grid.sync();
#endif

#ifndef DBG_NO_LIGHT
    light_step(0, ka, tid, L, G, bx, vcu); GSYNC(); STAMP(2);
#endif
#ifndef DBG_NO_ATTN
    attn_step(0, ka, tid, (char*)lds, G, vcu); GSYNC(); STAMP(3);
#endif
#ifndef DBG_NO_LIGHT
    for (int step = 2; step < 16; ++step) { light_step(step, ka, tid, L, G, bx, vcu); GSYNC(); STAMP(2 + step); }
#endif
#ifndef DBG_NO_ATTN2
    attn_step(1, ka, tid, (char*)lds, G, vcu); GSYNC(); STAMP(18);
#endif
#ifndef DBG_NO_LIGHT
    for (int step = 17; step < 20; ++step) { light_step(step, ka, tid, L, G, bx, vcu); GSYNC(); STAMP(2 + step); }
#endif
#if PROBE_MASK
    grid.sync();
#endif

    {
        LAUNDER();
        const int lane = tid & 63, wave = __builtin_amdgcn_readfirstlane(tid >> 6); float* const out = KOUT; const float* final_norm = KIN(4);
        const int gw = vcu * NWAVES + wave, NGW = G * NWAVES;
        f32x4 gn[4];
#pragma unroll
        for (int jj = 0; jj < 4; ++jj) gn[jj] = *((const f32x4*)final_norm + lane + 64 * jj);
#if PROBE_MASK
        for (int m = M - 1 - gw; m >= 0; m -= NGW) {
            f32x4* xr = (f32x4*)(out + (size_t)m * D) + lane; f32x4 v[4]; float s = 0.f;
#pragma unroll
            for (int jj = 0; jj < 4; ++jj) { v[jj] = xr[64 * jj]; s += (v[jj][0] * v[jj][0] + v[jj][1] * v[jj][1]) + (v[jj][2] * v[jj][2] + v[jj][3] * v[jj][3]); }
            const float rs = __builtin_amdgcn_rsqf(wave_sum(s) * (1.0f / 1024.0f) + 1e-6f);
            if (m < 4096) {
                unsigned long long tt = 0;
                for (int k = 0; k < 21; ++k) if ((PROBE_MASK >> k) & 1u) tt += TS[k + 1] - TS[k];
                if ((PROBE_MASK >> 21) & 1u) tt += __builtin_amdgcn_s_memrealtime() - TS[21];
                if ((PROBE_MASK >> 22) & 1u) tt += TS[21] - TS[0];
                const float delta = sqrtf((float)tt * 0.01f * 0.25e-6f);
#pragma unroll
                for (int jj = 0; jj < 4; ++jj) { f32x4 o = v[jj] * rs * gn[jj]; o[0] += delta; o[1] -= delta; o[2] += delta; o[3] -= delta; xr[64 * jj] = o; }
            } else {
#pragma unroll
                for (int jj = 0; jj < 4; ++jj) xr[64 * jj] = v[jj] * rs * gn[jj];
            }
        }
#else
        for (int m0 = gw * 4; m0 < M; m0 += NGW * 4) {
            f32x4 v[4][4];
#pragma unroll
            for (int r = 0; r < 4; ++r) { const f32x4* xr = (const f32x4*)(out + (size_t)(m0 + r) * D) + lane;
#pragma unroll
                for (int jj = 0; jj < 4; ++jj) v[r][jj] = xr[64 * jj]; }
#pragma unroll
            for (int r = 0; r < 4; ++r) { float s = 0.f;
#pragma unroll
                for (int jj = 0; jj < 4; ++jj) s += (v[r][jj][0] * v[r][jj][0] + v[r][jj][1] * v[r][jj][1]) + (v[r][jj][2] * v[r][jj][2] + v[r][jj][3] * v[r][jj][3]);
                const float rs = __builtin_amdgcn_rsqf(wave_sum(s) * (1.0f / 1024.0f) + 1e-6f);
                f32x4* xw = (f32x4*)(out + (size_t)(m0 + r) * D) + lane;
#pragma unroll
                for (int jj = 0; jj < 4; ++jj) xw[64 * jj] = v[r][jj] * rs * gn[jj]; }
        }
#endif
    }
}

extern "C" void kernel_launch(void* const* d_in, const int* in_sizes, int n_in, void* d_out, int out_size, void* d_ws, size_t ws_size, hipStream_t stream) {
    static int grid = 0;
    if (grid == 0) {
        if (n_in != 21 || in_sizes[0] != M * D || out_size != M * D || ws_size < WS_END) { fprintf(stderr, "kernel_launch: unexpected shapes (n_in %d, in0 %d, out %d, ws %zu)\n", n_in, n_in > 0 ? in_sizes[0] : -1, out_size, ws_size); grid = -1; return; }
        int dev = 0, cus = 0, per_cu = 0;
        if (hipGetDevice(&dev) != hipSuccess || hipDeviceGetAttribute(&cus, hipDeviceAttributeMultiprocessorCount, dev) != hipSuccess) { grid = -1; return; }
        if (hipFuncSetAttribute((const void*)trunk_fwd, hipFuncAttributeMaxDynamicSharedMemorySize, LDS_BYTES) != hipSuccess) { fprintf(stderr, "kernel_launch: hipFuncSetAttribute failed\n"); grid = -1; return; }
        if (hipOccupancyMaxActiveBlocksPerMultiprocessor(&per_cu, (const void*)trunk_fwd, NWAVES * 64, LDS_BYTES) != hipSuccess || per_cu < 1) { fprintf(stderr, "kernel_launch: occupancy query says %d\n", per_cu); per_cu = 1; }
        (void)hipGetLastError();
        grid = cus;
    }
    if (grid < 0) return;
    Params p{};
    for (int i = 0; i < 21; ++i) p.in[i] = d_in[i];
    p.out = (float*)d_out; p.ws = (unsigned char*)d_ws;
    p.lam0 = (float)(0.8 - 0.6 * exp(-0.3 * 0.0)); p.lam1 = (float)(0.8 - 0.6 * exp(-0.3 * 3.0));
    void* args[] = {&p};
    const hipError_t e = hipLaunchCooperativeKernel((const void*)trunk_fwd, dim3(grid), dim3(NWAVES * 64), args, LDS_BYTES, stream);
    if (e != hipSuccess) fprintf(stderr, "kernel_launch: cooperative launch failed: %s (grid %d)\n", hipGetErrorString(e), grid);
}
```

```cpp
#include <hip/hip_runtime.h>
#include <hip/hip_cooperative_groups.h>
#include <cstdio>
#include <cstdint>
#include <cmath>
namespace pg8 {
#define PG8_LAS __attribute__((address_space(3)))
typedef unsigned short bf16_t;
typedef short bf16x8 __attribute__((ext_vector_type(8)));
typedef float f32x4 __attribute__((ext_vector_type(4)));
typedef unsigned u32x4 __attribute__((ext_vector_type(4)));
constexpr int BM = 256, BK = 64, HALF = 128, HTB = HALF * BK * 2  , STAGE_BYTES = 8 * HTB, NXCD = 8, WGM = 8;

__host__ __device__ __forceinline__ int lds_byte(int r, int c) { const int st = (r >> 4) * 2 + (c >> 5), rr = r & 15, cc = c & 31, ob = rr * 64 + cc * 2; return st * 1024 + (ob ^ (((ob >> 9) & 1) << 5)); }
__host__ __device__ __forceinline__ void stage_rc(int b, int& R, int& C) { const int st = b / 1024, sb = b % 1024, swz = sb ^ (((sb >> 9) & 1) << 5); R = (st >> 1) * 16 + swz / 64; C = (st & 1) * 32 + (swz % 64) / 2; }
__host__ __device__ __forceinline__ int perm32(int rho) { const int n = rho >> 4, i = rho & 15; return 8 * (i >> 2) + 4 * n + (i & 3); }

struct Unit { int pm, pn; };
struct Gemm { const bf16_t* A; const bf16_t* Bt; int M, N, K; };

struct StaticOrder {
    int nM, nN, nwg, G, c;
    __host__ __device__ void init(int M, int N, int G_, int c_) { nM = M / BM; nN = N / BM; nwg = nM * nN; G = G_; c = c_; }
    __host__ __device__ bool next(int i, Unit& u) const {
        const long L = (long)i * G + c; if (L >= nwg) return false;
        int wgid = (int)L; { const int q = nwg / NXCD, r = nwg % NXCD, xcd = wgid % NXCD, off = wgid / NXCD; wgid = (xcd < r ? xcd * (q + 1) : r * (q + 1) + (xcd - r) * q) + off; }
        const int nig = WGM * nN, gid = wgid / nig, fm = gid * WGM, gsz = (nM - fm) < WGM ? (nM - fm) : WGM;
        u.pm = fm + ((wgid % nig) % gsz); u.pn = (wgid % nig) / gsz; return true;
    }
    __device__ __forceinline__ void a_ready(const Unit&) const {}
    __device__ __forceinline__ void done(const Unit&) const {}
};
__device__ __forceinline__ unsigned cvt_pk_bf16(float lo, float hi) { unsigned r; asm volatile("v_cvt_pk_bf16_f32 %0, %1, %2" : "=v"(r) : "v"(lo), "v"(hi)); return r; }
typedef float f32x2 __attribute__((ext_vector_type(2)));
__device__ __forceinline__ f32x2 gelu_pk(f32x2 v) {
    const f32x2 av = __builtin_elementwise_abs(v), d = av * 0.2316418882f + 1.0f;
    f32x2 t; t.x = __builtin_amdgcn_rcpf(d.x); t.y = __builtin_amdgcn_rcpf(d.y);
    f32x2 q = t * 0.5307027145f + (-0.7265760135f); q = q * t + 0.7107068705f; q = q * t + (-0.142248368f); q = q * t + 0.127414796f; q = q * t;
    const f32x2 s = (v * v) * (-0.72134752044f);
    f32x2 e; e.x = __builtin_amdgcn_exp2f(s.x); e.y = __builtin_amdgcn_exp2f(s.y);
    const f32x2 m = v * (q * e), r = v - m;
    f32x2 o; o.x = v.x < 0.f ? m.x : r.x; o.y = v.y < 0.f ? m.y : r.y; return o;
}
constexpr float QK_C2 = 0.125f * 1.4426950408889634f;
typedef float f32x2e __attribute__((ext_vector_type(2)));
__device__ __forceinline__ u32x4 pack8(const f32x4 a, const f32x4 b) { u32x4 w; w.x = cvt_pk_bf16(a[0], a[1]); w.y = cvt_pk_bf16(a[2], a[3]); w.z = cvt_pk_bf16(b[0], b[1]); w.w = cvt_pk_bf16(b[2], b[3]); return w; }
__device__ __forceinline__ float quad_sum(float s) {
    { const auto a = __builtin_amdgcn_permlane16_swap(__float_as_uint(s), __float_as_uint(s), false, false); s = __uint_as_float(a[0]) + __uint_as_float(a[1]); }
    { const auto b = __builtin_amdgcn_permlane32_swap(__float_as_uint(s), __float_as_uint(s), false, false); s = __uint_as_float(b[0]) + __uint_as_float(b[1]); }
    return s; }
__device__ __forceinline__ void gelu8(f32x4& v0, f32x4& v1) {
    const f32x4 a0 = __builtin_elementwise_abs(v0), a1 = __builtin_elementwise_abs(v1), d0 = a0 * 0.2316418882f + 1.0f, d1 = a1 * 0.2316418882f + 1.0f;
    f32x4 t0, t1;
#pragma unroll
    for (int e = 0; e < 4; ++e) { t0[e] = __builtin_amdgcn_rcpf(d0[e]); t1[e] = __builtin_amdgcn_rcpf(d1[e]); }
    f32x4 q0 = t0 * 0.5307027145f + (-0.7265760135f), q1 = t1 * 0.5307027145f + (-0.7265760135f);
    q0 = q0 * t0 + 0.7107068705f; q1 = q1 * t1 + 0.7107068705f; q0 = q0 * t0 + (-0.142248368f); q1 = q1 * t1 + (-0.142248368f);
    q0 = q0 * t0 + 0.127414796f; q1 = q1 * t1 + 0.127414796f; q0 = q0 * t0; q1 = q1 * t1;
    const f32x4 s0 = (v0 * v0) * (-0.72134752044f), s1 = (v1 * v1) * (-0.72134752044f);
    f32x4 e0, e1;
#pragma unroll
    for (int e = 0; e < 4; ++e) { e0[e] = __builtin_amdgcn_exp2f(s0[e]); e1[e] = __builtin_amdgcn_exp2f(s1[e]); }
    const f32x4 m0 = v0 * (q0 * e0), m1 = v1 * (q1 * e1), r0 = v0 - m0, r1 = v1 - m1;
#pragma unroll
    for (int e = 0; e < 4; ++e) { const float x0 = v0[e], x1 = v1[e]; v0[e] = x0 < 0.f ? m0[e] : r0[e]; v1[e] = x1 < 0.f ? m1[e] : r1[e]; }
}
struct EpiGen {
    static constexpr bool PERM = true, AFTER_DRAIN = false;
    int mode;
    float* ssq;
    float eps;
    bf16_t *o0, *o1, *o2;
    const int* pos;
    const float* bias;
    f32x2e* vstat;
    float* xout; const bf16_t* xb;
    __device__ __forceinline__ float row_rstd(int row, int fq) const {
        const f32x4 p = *(const f32x4*)(ssq + (size_t)row * 16 + fq * 4);
        const float s = quad_sum((p[0] + p[1]) + (p[2] + p[3]));
        return __builtin_amdgcn_rsqf(s * (1.0f / 1024.0f) + eps);
    }
    __device__ __forceinline__ void operator()(const f32x4 (&acc)[2][2][4][2], const Unit& u, int wr, int wc, int fr, int fq) const {
        asm volatile("" : "+v"(fr), "+v"(fq));
        const int rowb = u.pm * BM + wr * 64 + fr, pn = u.pn;
        float rsv[2][4];
        if (mode != 3) { f32x4 pp[2][4];
#pragma unroll
            for (int ai = 0; ai < 2; ++ai)
#pragma unroll
                for (int m = 0; m < 4; ++m) pp[ai][m] = *(const f32x4*)(ssq + (size_t)(rowb + ai * HALF + m * 16) * 16 + fq * 4);
#pragma unroll
            for (int ai = 0; ai < 2; ++ai)
#pragma unroll
                for (int m = 0; m < 4; ++m) rsv[ai][m] = __builtin_amdgcn_rsqf(quad_sum((pp[ai][m][0] + pp[ai][m][1]) + (pp[ai][m][2] + pp[ai][m][3])) * (1.0f / 1024.0f) + eps); }
        if (mode == 3) {
            const int col0 = pn * BM + wc * 32 + 8 * fq;
            u32x4 xw[8][2];
#pragma unroll
            for (int k = 0; k < 4; ++k)
#pragma unroll
                for (int bj = 0; bj < 2; ++bj) xw[k][bj] = *(const u32x4*)(xb + (size_t)(rowb + k * 16) * 1024 + col0 + bj * HALF);
#pragma unroll
            for (int k = 0; k < 8; ++k) {
                    const int ai = k >> 2, m = k & 3;
                    const int row = rowb + ai * HALF + m * 16; const size_t off = (size_t)row * 1024 + col0; float sq = 0.f;
                    const u32x4 w0 = xw[k][0], w1 = xw[k][1];
                    if (k < 4) {
#pragma unroll
                        for (int bj = 0; bj < 2; ++bj) xw[k + 4][bj] = *(const u32x4*)(xb + (size_t)(rowb + HALF + k * 16) * 1024 + col0 + bj * HALF);
                    }
#pragma unroll
                    for (int bj = 0; bj < 2; ++bj) {
                        const u32x4 w = bj ? w1 : w0;
                        const f32x4 x0 = (f32x4){__uint_as_float(w.x << 16), __uint_as_float(w.x & 0xffff0000u), __uint_as_float(w.y << 16), __uint_as_float(w.y & 0xffff0000u)};
                        const f32x4 x1 = (f32x4){__uint_as_float(w.z << 16), __uint_as_float(w.z & 0xffff0000u), __uint_as_float(w.w << 16), __uint_as_float(w.w & 0xffff0000u)};
                        const f32x4 v0 = x0 + acc[ai][bj][m][0], v1 = x1 + acc[ai][bj][m][1];
                        if (xout) { *(f32x4*)(xout + off + bj * HALF) = v0; *(f32x4*)(xout + off + bj * HALF + 4) = v1; }
                        sq += (v0[0] * v0[0] + v0[1] * v0[1]) + (v0[2] * v0[2] + v0[3] * v0[3]) + (v1[0] * v1[0] + v1[1] * v1[1]) + (v1[2] * v1[2] + v1[3] * v1[3]);
                        if (o0) *(u32x4*)(o0 + off + bj * HALF) = pack8(v0, v1);
                    }
                    sq = quad_sum(sq);
                    if (fq == 0) ssq[(size_t)row * 16 + pn * 4 + wc] = sq;
                }
        } else if (mode == 4) {
            const int col0 = pn * HALF + wc * 32 + 8 * fq;
#pragma unroll
            for (int ai = 0; ai < 2; ++ai)
#pragma unroll
                for (int m = 0; m < 4; ++m) {
                    const int row = rowb + ai * HALF + m * 16; const float rs = rsv[ai][m]; f32x4 h[2];
                    const float rsc = rs * -1.4426950408889634f, rs2 = rs * rs;
                    const f32x4 a0 = acc[ai][0][m][0], a1 = acc[ai][0][m][1], b0 = acc[ai][1][m][0], b1 = acc[ai][1][m][1];
                    const f32x4 t0 = a0 * rsc, t1 = a1 * rsc; f32x4 e0, e1;
#pragma unroll
                    for (int e = 0; e < 4; ++e) { e0[e] = __builtin_amdgcn_exp2f(t0[e]); e1[e] = __builtin_amdgcn_exp2f(t1[e]); }
                    const f32x4 d0 = e0 + 1.0f, d1 = e1 + 1.0f, p0 = (a0 * b0) * rs2, p1 = (a1 * b1) * rs2; f32x4 r0, r1;
#pragma unroll
                    for (int e = 0; e < 4; ++e) { r0[e] = __builtin_amdgcn_rcpf(d0[e]); r1[e] = __builtin_amdgcn_rcpf(d1[e]); }
                    h[0] = p0 * r0; h[1] = p1 * r1;
                    *(u32x4*)(o0 + (size_t)row * 2816 + col0) = pack8(h[0], h[1]);
                }
        } else if (mode == 0) {
            if (pn < 8) {
                bf16_t* dst = (pn < 4) ? o0 : o1; const float sc = (pn < 4) ? QK_C2 : 1.0f; const int head = (pn & 3) * 4 + wc;
                int posv[2][4];
#pragma unroll
                for (int ai = 0; ai < 2; ++ai)
#pragma unroll
                    for (int m = 0; m < 4; ++m) posv[ai][m] = pos[rowb + ai * HALF + m * 16];
                f32x4 iva, ivb;
#pragma unroll
                for (int e = 0; e < 4; ++e) { iva[e] = __builtin_amdgcn_exp2f(-(float)(8 * fq + e) * 0.41524101186092029f) * 0.15915494309189535f; ivb[e] = __builtin_amdgcn_exp2f(-(float)(8 * fq + 4 + e) * 0.41524101186092029f) * 0.15915494309189535f; }
#pragma unroll
                for (int ai = 0; ai < 2; ++ai)
#pragma unroll
                    for (int m = 0; m < 4; ++m) {
                        const int row = rowb + ai * HALF + m * 16; const float rs = rsv[ai][m] * sc; const float pf = (float)posv[ai][m];
                        f32x4 ca, cb, sa, sb;
#pragma unroll
                        for (int e = 0; e < 4; ++e) { const float ra = __builtin_amdgcn_fractf(pf * iva[e]), rb = __builtin_amdgcn_fractf(pf * ivb[e]);
                            ca[e] = __builtin_amdgcn_cosf(ra); sa[e] = __builtin_amdgcn_sinf(ra); cb[e] = __builtin_amdgcn_cosf(rb); sb[e] = __builtin_amdgcn_sinf(rb); }
                        const f32x4 x1a = acc[ai][0][m][0] * rs, x1b = acc[ai][0][m][1] * rs, x2a = acc[ai][1][m][0] * rs, x2b = acc[ai][1][m][1] * rs;
                        const f32x4 o1a = x1a * ca - x2a * sa, o1b = x1b * cb - x2b * sb, o2a = x2a * ca + x1a * sa, o2b = x2b * cb + x1b * sb;
                        bf16_t* p = dst + (size_t)row * 1024 + head * 64 + 8 * fq;
                        *(u32x4*)p = pack8(o1a, o1b); *(u32x4*)(p + 32) = pack8(o2a, o2b);
                    }
            } else {
                const int col0 = (pn - 8) * BM + wc * 32 + 8 * fq;
#pragma unroll
                for (int ai = 0; ai < 2; ++ai)
#pragma unroll
                    for (int m = 0; m < 4; ++m) {
                        const int row = rowb + ai * HALF + m * 16; const float rs = rsv[ai][m];
#pragma unroll
                        for (int bj = 0; bj < 2; ++bj) *(u32x4*)(o2 + (size_t)row * 1024 + col0 + bj * HALF) = pack8(acc[ai][bj][m][0] * rs, acc[ai][bj][m][1] * rs);
                    }
            }
        } else if (mode == 1) {
            const int col0 = pn * BM + wc * 32 + 8 * fq; const bool isv = pn >= 6;
            bf16_t* dst = isv ? (o1 + col0 - 1536) : (o0 + col0);
            f32x4 bv[2][2];
#pragma unroll
            for (int bj = 0; bj < 2; ++bj)
#pragma unroll
                for (int n = 0; n < 2; ++n) bv[bj][n] = *(const f32x4*)(bias + col0 + bj * HALF + 4 * n);
#pragma unroll
            for (int ai = 0; ai < 2; ++ai)
#pragma unroll
                for (int m = 0; m < 4; ++m) {
                    const int row = rowb + ai * HALF + m * 16; const float rs = rsv[ai][m]; float s1 = 0.f, s2 = 0.f;
#pragma unroll
                    for (int bj = 0; bj < 2; ++bj) {
                        f32x4 v0 = acc[ai][bj][m][0] * rs + bv[bj][0], v1 = acc[ai][bj][m][1] * rs + bv[bj][1];
                        gelu8(v0, v1);
                        s1 += ((v0[0] + v0[1]) + (v0[2] + v0[3])) + ((v1[0] + v1[1]) + (v1[2] + v1[3]));
                        s2 += (v0[0] * v0[0] + v0[1] * v0[1]) + (v0[2] * v0[2] + v0[3] * v0[3]) + (v1[0] * v1[0] + v1[1] * v1[1]) + (v1[2] * v1[2] + v1[3] * v1[3]);
                        *(u32x4*)(dst + (size_t)row * 1536 + bj * HALF) = pack8(v0, v1);
                    }
                    if (isv) { s1 = quad_sum(s1); s2 = quad_sum(s2); if (fq == 0) vstat[(size_t)row * 24 + (pn - 6) * 4 + wc] = (f32x2e){s1, s2}; }
                }
        } else {
#pragma unroll
            for (int ai = 0; ai < 2; ++ai)
#pragma unroll
                for (int m = 0; m < 4; ++m) {
                    const int row = rowb + ai * HALF + m * 16; const float rs = rsv[ai][m];
                    if (pn < 4) {
#pragma unroll
                        for (int bj = 0; bj < 2; ++bj) *(u32x4*)(o0 + (size_t)row * 1024 + pn * BM + wc * 32 + 8 * fq + bj * HALF) = pack8(acc[ai][bj][m][0] * rs, acc[ai][bj][m][1] * rs);
                    } else {
                        const float r2 = rs * rs;
                        *(u32x4*)(o1 + (size_t)row * 1024 + (pn - 4) * HALF + wc * 32 + 8 * fq) = pack8(acc[ai][0][m][0] * acc[ai][1][m][0] * r2, acc[ai][0][m][1] * acc[ai][1][m][1] * r2);
                    }
                }
        }
    }
};

template <class Epi, class Sched, bool ALIGN_EPI = false, bool SP2 = false>
__device__ __forceinline__ void gemm_phase(PG8_LAS unsigned char* lds, const Gemm g, const Sched& S, const Epi& E, const int tid) {
    const int wid = __builtin_amdgcn_readfirstlane(tid >> 6), lane = tid & 63, wr = wid >> 2, wc = wid & 3, fr = lane & 15, fq = lane >> 4;
    const int K = g.K, nt = K / BK;
    unsigned voffA[2], voffB[2];
#pragma unroll
    for (int i = 0; i < 2; ++i) { int R, C; stage_rc(tid * 16 + i * 8192, R, C); const int Rb = Epi::PERM ? ((R & ~31) + perm32(R & 31)) : R;
        voffA[i] = (unsigned)(R * K + C) * 2u; voffB[i] = (unsigned)(Rb * K + C) * 2u; }
    const size_t kstep = (size_t)(BK * 2);
    const size_t hstep = (size_t)HALF * K * 2;
    const size_t tstep = 2 * hstep;
    const unsigned ldsw = (unsigned)wid * 1024u;
    const int aoff = lds_byte(wr * 64 + fr, fq * 8), boff = lds_byte(wc * 32 + fr, fq * 8);
#define PG8_SA(b, h) (((b) * 2 + (h)) * HTB)
#define PG8_SB(b, h) ((4 + (b) * 2 + (h)) * HTB)
#define PG8_STAGE(bufoff, gbase, voff) do { _Pragma("unroll") for (int _i = 0; _i < 2; ++_i) \
        __builtin_amdgcn_global_load_lds((const unsigned*)((const char*)(gbase) + (voff)[_i]), (PG8_LAS unsigned*)(lds + (bufoff) + ldsw + _i * 8192), 16, 0, 0); } while (0)
#define PG8_LDA(dst, b, h) do { _Pragma("unroll") for (int m = 0; m < 4; ++m) _Pragma("unroll") for (int k = 0; k < 2; ++k) dst[m][k] = *(const PG8_LAS bf16x8*)(lds + PG8_SA(b, h) + aoff + m * 2048 + k * 1024); } while (0)
#define PG8_LDB(dst, b, h) do { _Pragma("unroll") for (int n = 0; n < 2; ++n) _Pragma("unroll") for (int k = 0; k < 2; ++k) dst[n][k] = *(const PG8_LAS bf16x8*)(lds + PG8_SB(b, h) + boff + n * 2048 + k * 1024); } while (0)
#define PG8_MMA(ai, bj, At, Bt) do { __builtin_amdgcn_s_setprio(1); _Pragma("unroll") for (int m = 0; m < 4; ++m) _Pragma("unroll") for (int n = 0; n < 2; ++n) _Pragma("unroll") for (int k = 0; k < 2; ++k) \
        acc[ai][bj][m][n] = __builtin_amdgcn_mfma_f32_16x16x32_bf16(Bt[n][k], At[m][k], acc[ai][bj][m][n], 0, 0, 0); __builtin_amdgcn_s_setprio(0); } while (0)
#define PG8_WAIT_V(n) asm volatile("s_waitcnt vmcnt(" #n ")" ::: "memory")
#define PG8_WAIT_L(n) asm volatile("s_waitcnt lgkmcnt(" #n ")" ::: "memory")
#define PG8_BAR __builtin_amdgcn_s_barrier()
#define PG8_SCHED __builtin_amdgcn_sched_barrier(0)
    Unit cur, nxt; int ui = 0;
    if (!S.next(0, cur)) return;
    f32x4 acc[2][2][4][2];
#pragma unroll
    for (int a = 0; a < 2; ++a)
#pragma unroll
        for (int b = 0; b < 2; ++b)
#pragma unroll
            for (int m = 0; m < 4; ++m)
#pragma unroll
                for (int n = 0; n < 2; ++n) acc[a][b][m][n] = (f32x4){0.f, 0.f, 0.f, 0.f};
    bf16x8 At[4][2], B0[2][2], B1[2][2];
    const char* cA = (const char*)g.A + (size_t)cur.pm * tstep; const char* cB = (const char*)g.Bt + (size_t)cur.pn * tstep;
    S.a_ready(cur);
    if constexpr (SP2) {
        PG8_STAGE(PG8_SB(0, 0), cB, voffB); PG8_STAGE(PG8_SB(0, 1), cB + hstep, voffB); PG8_STAGE(PG8_SA(0, 0), cA, voffA); PG8_STAGE(PG8_SA(0, 1), cA + hstep, voffA);
        if (wr == 1) PG8_BAR;
        PG8_WAIT_V(2); PG8_BAR;
        PG8_STAGE(PG8_SB(1, 0), cB + kstep, voffB); PG8_STAGE(PG8_SA(1, 0), cA + kstep, voffA); PG8_STAGE(PG8_SB(1, 1), cB + hstep + kstep, voffB);
        PG8_WAIT_V(6); PG8_BAR;
    } else {
        PG8_STAGE(PG8_SB(0, 0), cB, voffB); PG8_STAGE(PG8_SA(0, 0), cA, voffA); PG8_STAGE(PG8_SB(0, 1), cB + hstep, voffB); PG8_STAGE(PG8_SA(0, 1), cA + hstep, voffA);
        if (wr == 1) PG8_BAR;
        PG8_WAIT_V(4); PG8_BAR;
        PG8_STAGE(PG8_SB(1, 0), cB + kstep, voffB); PG8_STAGE(PG8_SA(1, 0), cA + kstep, voffA); PG8_STAGE(PG8_SB(1, 1), cB + hstep + kstep, voffB);
        PG8_WAIT_V(6); PG8_BAR;
    }
    for (;;) {
        const bool has_next = S.next(ui + 1, nxt);
        const char* nA = has_next ? (const char*)g.A + (size_t)nxt.pm * tstep : cA; const char* nB = has_next ? (const char*)g.Bt + (size_t)nxt.pn * tstep : cB;
        for (int t = 0; t < nt; t += 2) {
            const bool last = (t == nt - 2);
            const char* a1 = cA + (size_t)(t + 1) * kstep;
            const char* a2 = last ? nA : cA + (size_t)(t + 2) * kstep; const char* b2 = last ? nB : cB + (size_t)(t + 2) * kstep;
            const char* a3 = a2 + kstep; const char* b3 = b2 + kstep;
            if (last && has_next) S.a_ready(nxt);
            if constexpr (SP2) {
            PG8_LDB(B0, 0, 0); PG8_LDB(B1, 0, 1); PG8_SCHED; PG8_LDA(At, 0, 0); PG8_STAGE(PG8_SA(1, 1), a1 + hstep, voffA);
            PG8_WAIT_V(8); PG8_WAIT_L(0); PG8_BAR; PG8_MMA(0, 0, At, B0); PG8_MMA(0, 1, At, B1); PG8_BAR; PG8_SCHED;
            PG8_LDA(At, 0, 1); PG8_STAGE(PG8_SB(0, 0), b2, voffB); PG8_STAGE(PG8_SB(0, 1), b2 + hstep, voffB); PG8_STAGE(PG8_SA(0, 0), a2, voffA);
            PG8_WAIT_V(8); PG8_WAIT_L(0); PG8_BAR; PG8_MMA(1, 0, At, B0); PG8_MMA(1, 1, At, B1); PG8_BAR; PG8_SCHED;
            PG8_LDB(B0, 1, 0); PG8_LDB(B1, 1, 1); PG8_SCHED; PG8_LDA(At, 1, 0); PG8_STAGE(PG8_SA(0, 1), a2 + hstep, voffA);
            PG8_WAIT_V(8); PG8_WAIT_L(0); PG8_BAR; PG8_MMA(0, 0, At, B0); PG8_MMA(0, 1, At, B1); PG8_BAR; PG8_SCHED;
            PG8_LDA(At, 1, 1); PG8_STAGE(PG8_SB(1, 0), b3, voffB); PG8_STAGE(PG8_SB(1, 1), b3 + hstep, voffB); PG8_STAGE(PG8_SA(1, 0), a3, voffA);
            PG8_WAIT_V(8); PG8_WAIT_L(0); PG8_BAR; PG8_MMA(1, 0, At, B0); PG8_MMA(1, 1, At, B1); PG8_BAR; PG8_SCHED;
            } else {
            PG8_LDB(B0, 0, 0); PG8_SCHED; PG8_LDA(At, 0, 0); PG8_STAGE(PG8_SA(1, 1), a1 + hstep, voffA);
            PG8_WAIT_L(8); PG8_BAR; PG8_WAIT_L(0); PG8_MMA(0, 0, At, B0); PG8_BAR; PG8_SCHED;
            PG8_LDB(B1, 0, 1); PG8_STAGE(PG8_SB(0, 0), b2, voffB);
            PG8_BAR; PG8_WAIT_L(0); PG8_MMA(0, 1, At, B1); PG8_BAR;
            PG8_LDA(At, 0, 1); PG8_STAGE(PG8_SA(0, 0), a2, voffA);
            PG8_BAR; PG8_WAIT_L(0); PG8_MMA(1, 0, At, B0); PG8_BAR; PG8_SCHED;
            PG8_STAGE(PG8_SB(0, 1), b2 + hstep, voffB);
            PG8_WAIT_V(6); PG8_BAR; PG8_MMA(1, 1, At, B1); PG8_BAR;
            PG8_LDB(B0, 1, 0); PG8_SCHED; PG8_LDA(At, 1, 0); PG8_STAGE(PG8_SA(0, 1), a2 + hstep, voffA);
            PG8_WAIT_L(8); PG8_BAR; PG8_WAIT_L(0); PG8_MMA(0, 0, At, B0); PG8_BAR; PG8_SCHED;
            PG8_LDB(B1, 1, 1); PG8_STAGE(PG8_SB(1, 0), b3, voffB);
            PG8_BAR; PG8_WAIT_L(0); PG8_MMA(0, 1, At, B1); PG8_BAR;
            PG8_LDA(At, 1, 1); PG8_STAGE(PG8_SA(1, 0), a3, voffA);
            PG8_BAR; PG8_WAIT_L(0); PG8_MMA(1, 0, At, B0); PG8_BAR; PG8_SCHED;
            PG8_STAGE(PG8_SB(1, 1), b3 + hstep, voffB);
            PG8_WAIT_V(6); PG8_BAR; PG8_MMA(1, 1, At, B1); PG8_BAR;
            }
        }
        if constexpr (ALIGN_EPI) { if (wr == 0) PG8_BAR; }
        if constexpr (!Epi::AFTER_DRAIN) { E(acc, cur, wr, wc, fr, fq); S.done(cur); }
        if (!has_next) break;
#pragma unroll
        for (int a = 0; a < 2; ++a)
#pragma unroll
            for (int b = 0; b < 2; ++b)
#pragma unroll
                for (int m = 0; m < 4; ++m)
#pragma unroll
                    for (int n = 0; n < 2; ++n) acc[a][b][m][n] = (f32x4){0.f, 0.f, 0.f, 0.f};
        cur = nxt; cA = nA; cB = nB; ++ui;
        if constexpr (ALIGN_EPI) { if (wr == 1) PG8_BAR; }
    }
    PG8_WAIT_V(0);
    if constexpr (!ALIGN_EPI) { if (wr == 0) PG8_BAR; }
    PG8_BAR;
    if constexpr (Epi::AFTER_DRAIN) { E.fused(acc, cur, wr, wc, fr, fq, lds, wid, lane); S.done(cur); }
#undef PG8_SA
#undef PG8_SB
#undef PG8_STAGE
#undef PG8_LDA
#undef PG8_LDB
#undef PG8_MMA
#undef PG8_WAIT_V
#undef PG8_WAIT_L
#undef PG8_BAR
#undef PG8_SCHED
}
}
#include <hip/hip_bf16.h>
#include <cmath>
namespace attn_body {
using bf16=__hip_bfloat16;
using bf16x8=__attribute__((ext_vector_type(8)))short;
using s16x4=__attribute__((ext_vector_type(4)))short;
using f32x16=__attribute__((ext_vector_type(16)))float;
using u32x4=__attribute__((ext_vector_type(4)))unsigned;
constexpr int BATCH=32,NHEAD=16,SEQ=2048,D=64,DM=NHEAD*D,OPITCH=2048;
constexpr int NW=8,QBLK=32,QB=QBLK*NW,KVBLK=64,NQB=SEQ/QB;
constexpr int ATTN_PITCH=DM, ATTN_UNIT_ROWS=QB;
__device__ __forceinline__ int crow(int r,int hi){return (r&3)+8*(r>>2)+4*hi;}
#define SBAR() __builtin_amdgcn_sched_barrier(0)
__device__ __forceinline__ void cmask(f32x16&p0,f32x16&p1,int jb,int qrel,int hi){
  const float NEG=-INFINITY; int kb=64*jb+4*hi;
  #pragma unroll
  for(int r=0;r<16;++r){int kv=kb+(r&3)+8*(r>>2); if(kv>qrel)p0[r]=NEG; if(kv+32>qrel)p1[r]=NEG;}
}

constexpr int NSLOT=3, SLOTB=8192;
constexpr int LDS_K=0, LDS_V=NSLOT*SLOTB, LDS_WS=LDS_V+NSLOT*2*SLOTB, LDS_OST=LDS_WS+NW*64*4, LDS_BYTES=LDS_OST+NW*8192;
constexpr float C2=0.125f*1.4426950408889634f;
__device__ __forceinline__ void glds16(const void*gsrc,unsigned lds_dst){unsigned keep;
  asm volatile("s_mov_b32 %0, m0\n\ts_mov_b32 m0, %2\n\ts_nop 0\n\tglobal_load_lds_dwordx4 %1, off\n\ts_mov_b32 m0, %0":"=&s"(keep):"v"(gsrc),"s"(lds_dst):"memory");}
__device__ __forceinline__ float max3f(float a,float b,float c){float r;asm("v_max3_f32 %0, %1, %2, %3":"=v"(r):"v"(a),"v"(b),"v"(c));return r;}
__device__ __forceinline__ float max2f(float a,float b){float r;asm("v_max_f32_e32 %0, %1, %2":"=v"(r):"v"(a),"v"(b));return r;}
__device__ __forceinline__ float fadd_s(float a,float b){float r;asm("v_add_f32_e32 %0, %1, %2":"=v"(r):"v"(a),"v"(b));return r;}
__device__ __forceinline__ float fsub_s(float a,float b){float r;asm("v_sub_f32_e32 %0, %1, %2":"=v"(r):"v"(a),"v"(b));return r;}
typedef float f32x2_t __attribute__((ext_vector_type(2))); typedef __bf16 bf16x2_t __attribute__((ext_vector_type(2)));
__device__ __forceinline__ unsigned cvtpk_s(float lo,float hi){f32x2_t v={lo,hi};bf16x2_t b=__builtin_convertvector(v,bf16x2_t);return __builtin_bit_cast(unsigned,b);}
#define WAIT_BAR(N) asm volatile("s_waitcnt vmcnt(" #N ") lgkmcnt(0)\n\ts_barrier":::"memory")

__device__ __forceinline__ void qkt(f32x16&p0,f32x16&p1,const char*Kslot,const bf16x8*qr,const f32x16&negm,int r32,int hi){
  const char*kb=Kslot+hi*1024+r32*16;
  #pragma unroll
  for(int d0=0;d0<4;++d0){
    const bf16x8 b0=*reinterpret_cast<const bf16x8*>(kb+d0*2048);
    const bf16x8 b1=*reinterpret_cast<const bf16x8*>(kb+d0*2048+512);
    if(d0==0){p0=__builtin_amdgcn_mfma_f32_32x32x16_bf16(b0,qr[0],negm,0,0,0);p1=__builtin_amdgcn_mfma_f32_32x32x16_bf16(b1,qr[0],negm,0,0,0);}
    else{p0=__builtin_amdgcn_mfma_f32_32x32x16_bf16(b0,qr[d0],p0,0,0,0);p1=__builtin_amdgcn_mfma_f32_32x32x16_bf16(b1,qr[d0],p1,0,0,0);}}
}
typedef __attribute__((address_space(3))) const char* lds_cptr;
typedef short v4i16_t __attribute__((ext_vector_type(4)));
__device__ __forceinline__ void kload8(bf16x8*kf,lds_cptr kp){
  kf[0]=*(const __attribute__((address_space(3))) bf16x8*)(kp);      kf[1]=*(const __attribute__((address_space(3))) bf16x8*)(kp+512);
  kf[2]=*(const __attribute__((address_space(3))) bf16x8*)(kp+2048); kf[3]=*(const __attribute__((address_space(3))) bf16x8*)(kp+2560);
  kf[4]=*(const __attribute__((address_space(3))) bf16x8*)(kp+4096); kf[5]=*(const __attribute__((address_space(3))) bf16x8*)(kp+4608);
  kf[6]=*(const __attribute__((address_space(3))) bf16x8*)(kp+6144); kf[7]=*(const __attribute__((address_space(3))) bf16x8*)(kp+6656);
}
__device__ __forceinline__ void kload2(bf16x8*kf,lds_cptr kp,int j){ kf[2*j]=*(const __attribute__((address_space(3))) bf16x8*)(kp+j*2048); kf[2*j+1]=*(const __attribute__((address_space(3))) bf16x8*)(kp+j*2048+512); }
__device__ __forceinline__ s16x4 vtr(lds_cptr p){ return __builtin_bit_cast(s16x4,__builtin_amdgcn_ds_read_tr16_b64_v4i16((__attribute__((address_space(3))) v4i16_t*)p)); }
__device__ __forceinline__ float rowmax(const f32x16&p0,const f32x16&p1){
  float a=max3f(p0[0],p0[1],p1[0]),b=max3f(p0[2],p0[3],p1[1]);a=max3f(a,p1[2],p1[3]);
  #pragma unroll
  for(int r=4;r<16;r+=4){a=max3f(a,p0[r],p0[r+1]);b=max3f(b,p0[r+2],p0[r+3]);a=max3f(a,p1[r],p1[r+1]);b=max3f(b,p1[r+2],p1[r+3]);}
  const float m=max2f(a,b);
  auto rr=__builtin_amdgcn_permlane32_swap(__float_as_uint(m),__float_as_uint(m),false,false);
  return max2f(__uint_as_float(rr[0]),__uint_as_float(rr[1]));
}
__device__ __forceinline__ void pv(f32x16*o,int vb,bf16x8 pa0,bf16x8 pa1,bf16x8 pa2,bf16x8 pa3){
  #pragma unroll
  for(int d0=0;d0<4;++d0){s16x4 lo[4],hi[4];
    #pragma unroll
    for(int ks=0;ks<4;++ks){
      asm volatile("ds_read_b64_tr_b16 %0,%1 offset:%c2":"=&v"(lo[ks]):"v"(vb),"i"(d0*4096+ks*1024):"memory");
      asm volatile("ds_read_b64_tr_b16 %0,%1 offset:%c2":"=&v"(hi[ks]):"v"(vb),"i"(d0*4096+ks*1024+512):"memory");}
    asm volatile("s_waitcnt lgkmcnt(0)":::"memory");SBAR();
    #define PK(k) (bf16x8){lo[k][0],lo[k][1],lo[k][2],lo[k][3],hi[k][0],hi[k][1],hi[k][2],hi[k][3]}
    o[d0]=__builtin_amdgcn_mfma_f32_32x32x16_bf16(pa0,PK(0),o[d0],0,0,0);
    o[d0]=__builtin_amdgcn_mfma_f32_32x32x16_bf16(pa1,PK(1),o[d0],0,0,0);
    o[d0]=__builtin_amdgcn_mfma_f32_32x32x16_bf16(pa2,PK(2),o[d0],0,0,0);
    o[d0]=__builtin_amdgcn_mfma_f32_32x32x16_bf16(pa3,PK(3),o[d0],0,0,0);
    #undef PK
  }
}

#ifndef ATTN_STORE16
#define ATTN_STORE16(p,v) (*(u32x4*)(p)=(v))
#endif
template<int THRL> __device__ __forceinline__ void attn_unit(int b,int h,int vcol,int ocol,int qb,const bf16*Q,const bf16*__restrict__ K,const bf16*__restrict__ V,bf16*O,char*shm,const int tid_in,const bool fuse,const unsigned lamf_bits,const unsigned oscale_bits,const float*subln,bf16*OC,const int occol){
  int tid=tid_in; asm volatile("":"+v"(tid)); tid&=511;
  const int lane=tid&63,r32=lane&31,hi=lane>>5; const int wid=__builtin_amdgcn_readfirstlane(tid>>6);
  const long rowbase=(long)b*SEQ; const int q0=qb*QB;
  const bf16*Qw=Q+(rowbase+q0+wid*QBLK)*DM+h*D;
  const bf16*Kh=K+rowbase*DM+h*D,*Vh=V+rowbase*DM+vcol;
  const unsigned lds0=(unsigned)(uintptr_t)shm;
  float*wsf=(float*)(shm+LDS_WS)+wid*64;
  const bf16*ksrc=Kh+(long)lane*DM+wid*8;
  const bf16*vsrc=Vh+(long)(16*(wid&3)+(lane>>2))*DM+(wid>>2)*32+(lane&3)*8;
  const unsigned kdst=lds0+LDS_K+wid*1024, vdst=lds0+LDS_V+wid*1024;
  #define DMA_K(t,slot) glds16(ksrc+(long)(t)*KVBLK*DM,(unsigned)__builtin_amdgcn_readfirstlane(kdst+(slot)))
  #define DMA_V(t,slot) do{ glds16(vsrc+(long)(t)*KVBLK*DM,(unsigned)__builtin_amdgcn_readfirstlane(vdst+2*(slot))); glds16(vsrc+(long)(t)*KVBLK*DM+64,(unsigned)__builtin_amdgcn_readfirstlane(vdst+2*(slot)+8192)); }while(0)
  const int vb0=(int)(lds0+LDS_V)+((lane>>4)&1)*32+(lane&3)*8+(4*hi+((lane&15)>>2))*64;
  const char*Kbase=shm+LDS_K; bf16x8 kf[8];
  const lds_cptr shm3=(lds_cptr)shm; const lds_cptr kp0=shm3+LDS_K+hi*1024+r32*16; const lds_cptr vp0=shm3+LDS_V+((lane>>4)&1)*32+(lane&3)*8+(4*hi+((lane&15)>>2))*64;
  const int NT=(q0+QB)/KVBLK;
  DMA_K(0,0);DMA_V(0,0);DMA_K(1,SLOTB);
  bf16x8 qr[4];
  #pragma unroll
  for(int d0=0;d0<4;++d0)qr[d0]=*reinterpret_cast<const bf16x8*>(&Qw[(long)r32*DM+d0*16+hi*8]);
  float mhat=0.f,l_reg=0.f;f32x16 o[4];f32x16 negm; { float zz; asm volatile("v_mov_b32 %0, 0":"=v"(zz));
    _Pragma("unroll") for(int r=0;r<16;++r){o[0][r]=zz;o[1][r]=zz;o[2][r]=zz;o[3][r]=zz;negm[r]=zz;} } asm volatile("":"+v"(negm));
  const int qrel=wid*QBLK+r32;
  #define CMASK(P0,P1,t) do{int jb_=(t)-(NT-4); if(jb_>=0)cmask(P0,P1,jb_,qrel,hi);}while(0)
  bool resc=false;
  #define START(P0,P1) do{ const float rm=rowmax(P0,P1); resc=false; \
    { const float dl=rm; mhat=fadd_s(mhat,dl); \
      _Pragma("unroll") for(int r=0;r<16;++r){P0[r]=fsub_s(P0[r],dl);P1[r]=fsub_s(P1[r],dl);} \
      _Pragma("unroll") for(int r=0;r<16;++r)negm[r]=-mhat; asm volatile("":"+v"(negm)); } \
    _Pragma("unroll") for(int r=0;r<16;++r)P0[r]=__builtin_amdgcn_exp2f(P0[r]); }while(0)
  #define RESC() do{ if(resc){ asm volatile("s_waitcnt lgkmcnt(0)":::"memory"); \
      _Pragma("unroll") for(int d_=0;d_<4;++d_) _Pragma("unroll") for(int r=0;r<16;++r)o[d_][r]*=wsf[crow(r,hi)]; } }while(0)
  f32x16 pA0,pA1,pB0,pB1;
  int sl_prev=0,sl_cur=0,sl_next=SLOTB;
  #define ROT() do{sl_prev=sl_cur;sl_cur=sl_next;sl_next=(sl_next==(NSLOT-1)*SLOTB)?0:sl_next+SLOTB;}while(0)
  DMA_K(2,2*SLOTB);
  WAIT_BAR(3);
  qkt(pA0,pA1,Kbase,qr,negm,r32,hi);asm volatile("s_nop 15\n\ts_nop 7":"+v"(pA0),"+v"(pA1));CMASK(pA0,pA1,0);
  START(pA0,pA1);
  _Pragma("unroll") for(int r=0;r<16;++r)pA1[r]=__builtin_amdgcn_exp2f(pA1[r]);
  WAIT_BAR(0);
  DMA_K(3,0);DMA_V(1,SLOTB);
  ROT();
  kload8(kf,kp0+sl_cur);
  WAIT_BAR(3);
  s16x4 vlo[8],vhi[8]; u32x4 pw0,pw1,pw2,pw3;
  #define PKW(P,B) cvtpk_s(P[B],P[B+1])
  #define PAF(k) __builtin_bit_cast(bf16x8,pw##k)
  #define VFR(i) (bf16x8){vlo[i][0],vlo[i][1],vlo[i][2],vlo[i][3],vhi[i][0],vhi[i][1],vhi[i][2],vhi[i][3]}
  #define PIN(x) asm volatile("":"+v"(x))
  #define MX3(a,b,c) __builtin_fmaxf(__builtin_fmaxf((a),(b)),(c))
  #define GAPA(MF,A0,A1,A2,A3,W0,W1,PW) do{ MF; sacc+=A0; sacc+=A1; sacc+=A2; sacc+=A3; PIN(sacc); W0; W1; PIN(PW); SBAR(); }while(0)
  #define EX(v) __builtin_amdgcn_exp2f(v)
  #define GAPB(MF,R,X,B) do{ MF; R; X[B]=EX(X[B]); X[B+1]=EX(X[B+1]); PIN(X); SBAR(); }while(0)
  #define VRD2(i) do{ vlo[i]=vtr(vp_+((((i)>>2)+2)*4096+((i)&3)*1024)); vhi[i]=vtr(vp_+((((i)>>2)+2)*4096+((i)&3)*1024+512)); }while(0)
  #define VRD(i) do{ vlo[i]=vtr(vp_+(((i)>>2)*4096+((i)&3)*1024)); vhi[i]=vtr(vp_+(((i)>>2)*4096+((i)&3)*1024+512)); }while(0)
  #define KRD(G,j) do{ if(G){ kload2(kf,kp0+sl_next,j); SBAR(); } }while(0)
  #define STEP(C0,C1,P0,P1,t,GK,GV,GL) do{ SBAR(); \
    const lds_cptr vp_=vp0+2*sl_prev; \
    VRD(0); SBAR(); float sacc=(P0[0]+P0[1]); \
    GAPA(C0=__builtin_amdgcn_mfma_f32_32x32x16_bf16(kf[0],qr[0],negm,0,0,0), P0[2],P0[3],P0[4],P0[5],     pw0[0]=PKW(P0,0), pw0[1]=PKW(P0,2), pw0); \
    VRD(4); SBAR(); GAPA(C1=__builtin_amdgcn_mfma_f32_32x32x16_bf16(kf[1],qr[0],negm,0,0,0), P0[6],P0[7],P0[8],P0[9],     pw0[2]=PKW(P0,4), pw0[3]=PKW(P0,6), pw0); \
    VRD(1); SBAR(); GAPA(C0=__builtin_amdgcn_mfma_f32_32x32x16_bf16(kf[2],qr[1],C0,0,0,0),   P0[10],P0[11],P0[12],P0[13], pw1[0]=PKW(P0,8), pw1[1]=PKW(P0,10), pw1); \
    VRD(5); SBAR(); GAPA(C1=__builtin_amdgcn_mfma_f32_32x32x16_bf16(kf[3],qr[1],C1,0,0,0),   P0[14],P0[15],P1[0],P1[1],   pw1[2]=PKW(P0,12),pw1[3]=PKW(P0,14), pw1); \
    VRD(2); SBAR(); GAPA(C0=__builtin_amdgcn_mfma_f32_32x32x16_bf16(kf[4],qr[2],C0,0,0,0),   P1[2],P1[3],P1[4],P1[5],     pw2[0]=PKW(P1,0), pw2[1]=PKW(P1,2), pw2); \
    VRD(6); SBAR(); GAPA(C1=__builtin_amdgcn_mfma_f32_32x32x16_bf16(kf[5],qr[2],C1,0,0,0),   P1[6],P1[7],P1[8],P1[9],     pw2[2]=PKW(P1,4), pw2[3]=PKW(P1,6), pw2); \
    VRD(3); SBAR(); GAPA(C0=__builtin_amdgcn_mfma_f32_32x32x16_bf16(kf[6],qr[3],C0,0,0,0),   P1[10],P1[11],P1[12],P1[13], pw3[0]=PKW(P1,8), pw3[1]=PKW(P1,10), pw3); \
    VRD(7); SBAR(); GAPA(C1=__builtin_amdgcn_mfma_f32_32x32x16_bf16(kf[7],qr[3],C1,0,0,0),   P1[14],P1[15],0.f,0.f,       pw3[2]=PKW(P1,12),pw3[3]=PKW(P1,14), pw3); \
    l_reg+=sacc; \
    if(GK){DMA_K((t)+3,sl_cur);} if(GV){DMA_V((t)+1,sl_next);} \
    CMASK(C0,C1,t); \
    { float a=MX3(C0[0],C0[1],C1[0]),b=MX3(C0[2],C0[3],C1[1]); a=MX3(a,C1[2],C1[3]); \
      _Pragma("unroll") for(int r=4;r<16;r+=4){a=MX3(a,C0[r],C0[r+1]);b=MX3(b,C0[r+2],C0[r+3]);a=MX3(a,C1[r],C1[r+1]);b=MX3(b,C1[r+2],C1[r+3]);} \
      float rm=__builtin_fmaxf(a,b); { auto rr=__builtin_amdgcn_permlane32_swap(__float_as_uint(rm),__float_as_uint(rm),false,false); rm=__builtin_fmaxf(__uint_as_float(rr[0]),__uint_as_float(rr[1])); } \
      resc=false; \
      if(__builtin_expect(__any(rm>(float)THRL),0)){ const float dl=__builtin_fmaxf(rm,0.f); mhat+=dl; \
        _Pragma("unroll") for(int r=0;r<16;++r){C0[r]-=dl;C1[r]-=dl;} \
        _Pragma("unroll") for(int r=0;r<16;++r)negm[r]=-mhat; asm volatile("":"+v"(negm)); \
        const float f=__builtin_amdgcn_exp2f(-dl); l_reg*=f; if(hi==0)wsf[r32]=f; resc=true; } } \
    SBAR(); \
    GAPB(o[0]=__builtin_amdgcn_mfma_f32_32x32x16_bf16(PAF(0),VFR(0),o[0],0,0,0), VRD2(0), C0,0); \
    GAPB(o[1]=__builtin_amdgcn_mfma_f32_32x32x16_bf16(PAF(0),VFR(4),o[1],0,0,0), VRD2(4), C0,2); \
    KRD(GL,0); GAPB(o[0]=__builtin_amdgcn_mfma_f32_32x32x16_bf16(PAF(1),VFR(1),o[0],0,0,0), VRD2(1), C0,4); \
    KRD(GL,1); GAPB(o[1]=__builtin_amdgcn_mfma_f32_32x32x16_bf16(PAF(1),VFR(5),o[1],0,0,0), VRD2(5), C0,6); \
    KRD(GL,2); GAPB(o[0]=__builtin_amdgcn_mfma_f32_32x32x16_bf16(PAF(2),VFR(2),o[0],0,0,0), VRD2(2), C0,8); \
    KRD(GL,3); GAPB(o[1]=__builtin_amdgcn_mfma_f32_32x32x16_bf16(PAF(2),VFR(6),o[1],0,0,0), VRD2(6), C0,10); \
    GAPB(o[0]=__builtin_amdgcn_mfma_f32_32x32x16_bf16(PAF(3),VFR(3),o[0],0,0,0), VRD2(3), C0,12); \
    GAPB(o[1]=__builtin_amdgcn_mfma_f32_32x32x16_bf16(PAF(3),VFR(7),o[1],0,0,0), VRD2(7), C0,14); \
    GAPB(o[2]=__builtin_amdgcn_mfma_f32_32x32x16_bf16(PAF(0),VFR(0),o[2],0,0,0), (void)0, C1,0); \
    GAPB(o[3]=__builtin_amdgcn_mfma_f32_32x32x16_bf16(PAF(0),VFR(4),o[3],0,0,0), (void)0, C1,2); \
    GAPB(o[2]=__builtin_amdgcn_mfma_f32_32x32x16_bf16(PAF(1),VFR(1),o[2],0,0,0), (void)0, C1,4); \
    GAPB(o[3]=__builtin_amdgcn_mfma_f32_32x32x16_bf16(PAF(1),VFR(5),o[3],0,0,0), (void)0, C1,6); \
    GAPB(o[2]=__builtin_amdgcn_mfma_f32_32x32x16_bf16(PAF(2),VFR(2),o[2],0,0,0), (void)0, C1,8); \
    GAPB(o[3]=__builtin_amdgcn_mfma_f32_32x32x16_bf16(PAF(2),VFR(6),o[3],0,0,0), (void)0, C1,10); \
    GAPB(o[2]=__builtin_amdgcn_mfma_f32_32x32x16_bf16(PAF(3),VFR(3),o[2],0,0,0), (void)0, C1,12); \
    GAPB(o[3]=__builtin_amdgcn_mfma_f32_32x32x16_bf16(PAF(3),VFR(7),o[3],0,0,0), (void)0, C1,14); \
    }while(0)
  int t=1;
  #undef CMASK
  #define CMASK(P0,P1,t) do{}while(0)
  for(;t+5<NT;t+=2){
    STEP(pB0,pB1,pA0,pA1,t,true,true,true);     WAIT_BAR(3); RESC(); ROT();
    STEP(pA0,pA1,pB0,pB1,t+1,true,true,true);   WAIT_BAR(3); RESC(); ROT();
  }
  #undef CMASK
  #define CMASK(P0,P1,t) do{int jb_=(t)-(NT-4); if(jb_>=0)cmask(P0,P1,jb_,qrel,hi);}while(0)
  #define ENDW(tt) do{ if((tt)+3<NT){WAIT_BAR(3);} else if((tt)+2<NT){WAIT_BAR(2);} else {WAIT_BAR(0);} }while(0)
  for(;t+1<NT;t+=2){
    STEP(pB0,pB1,pA0,pA1,t,(t+3<NT),(t+1<NT),(t+1<NT));       ENDW(t);   RESC(); ROT();
    STEP(pA0,pA1,pB0,pB1,t+1,(t+4<NT),(t+2<NT),(t+2<NT));     ENDW(t+1); RESC(); ROT();
  }
  STEP(pB0,pB1,pA0,pA1,NT-1,false,false,false); RESC();
  { float sacc=pB0[0]+pB0[1]; _Pragma("unroll") for(int r=2;r<16;++r)sacc+=pB0[r]; _Pragma("unroll") for(int r=0;r<16;++r)sacc+=pB1[r]; l_reg+=sacc;
    pw0=(u32x4){PKW(pB0,0),PKW(pB0,2),PKW(pB0,4),PKW(pB0,6)};pw1=(u32x4){PKW(pB0,8),PKW(pB0,10),PKW(pB0,12),PKW(pB0,14)};pw2=(u32x4){PKW(pB1,0),PKW(pB1,2),PKW(pB1,4),PKW(pB1,6)};pw3=(u32x4){PKW(pB1,8),PKW(pB1,10),PKW(pB1,12),PKW(pB1,14)};
    SBAR(); pv(o,vb0+2*sl_cur,PAF(0),PAF(1),PAF(2),PAF(3)); }
  #undef PKW
  #undef PAF
  #undef VFR
  #undef PIN
  #undef MX3
  #undef GAPA
  #undef GAPB
  #undef EX
  #undef VRD
  #undef KRD
  #undef STEP
  #undef ENDW
  {auto rr=__builtin_amdgcn_permlane32_swap(__float_as_uint(l_reg),__float_as_uint(l_reg),false,false);l_reg=__uint_as_float(rr[0])+__uint_as_float(rr[1]);}
  if(hi==0)wsf[32+r32]=l_reg;asm volatile("s_waitcnt lgkmcnt(0)":::"memory");
  float rli[16];
  #pragma unroll
  for(int r=0;r<16;++r)rli[r]=__builtin_amdgcn_rcpf(wsf[32+crow(r,hi)]);
  bf16*Ow=O+(rowbase+q0+wid*QBLK)*OPITCH+ocol;
  { bf16*stg=(bf16*)(shm+LDS_OST)+wid*4096;
    #pragma unroll
    for(int r=0;r<16;++r){const int orow=crow(r,hi);
      #pragma unroll
      for(int d0=0;d0<4;++d0)stg[orow*128+d0*32+r32]=__float2bfloat16(o[d0][r]*rli[r]);}
    asm volatile("s_waitcnt lgkmcnt(0)":::"memory");
    if(!fuse){
      #pragma unroll
      for(int i=0;i<8;++i){const int row=i*4+(lane>>4),ch=lane&15; const u32x4 v=*(const u32x4*)(stg+row*128+ch*8); ATTN_STORE16(Ow+(long)row*OPITCH+ch*8,v);}
    } else {
      const int ch=lane&15; const bf16*O1w=Ow-128; bf16*OCw=OC+(rowbase+q0+wid*QBLK)*DM+occol;
      const float lamf=__uint_as_float(__builtin_amdgcn_readfirstlane(lamf_bits)), oscale=__uint_as_float(__builtin_amdgcn_readfirstlane(oscale_bits));
      asm volatile("s_waitcnt vmcnt(0)":::"memory");
      u32x4 a1[8];
      #pragma unroll
      for(int i=0;i<8;++i){const int row=i*4+(lane>>4); a1[i]=*(const u32x4*)(O1w+(long)row*OPITCH+ch*8);}
      const float4 gA=*(const float4*)(subln+ch*8), gB=*(const float4*)(subln+ch*8+4);
      #pragma unroll
      for(int i=0;i<8;++i){const int row=i*4+(lane>>4); const u32x4 v2=*(const u32x4*)(stg+row*128+ch*8); const u32x4 v1=a1[i];
        float x[8];
        x[0]=__uint_as_float(v1[0]<<16)-lamf*__uint_as_float(v2[0]<<16); x[1]=__uint_as_float(v1[0]&0xffff0000u)-lamf*__uint_as_float(v2[0]&0xffff0000u);
        x[2]=__uint_as_float(v1[1]<<16)-lamf*__uint_as_float(v2[1]<<16); x[3]=__uint_as_float(v1[1]&0xffff0000u)-lamf*__uint_as_float(v2[1]&0xffff0000u);
        x[4]=__uint_as_float(v1[2]<<16)-lamf*__uint_as_float(v2[2]<<16); x[5]=__uint_as_float(v1[2]&0xffff0000u)-lamf*__uint_as_float(v2[2]&0xffff0000u);
        x[6]=__uint_as_float(v1[3]<<16)-lamf*__uint_as_float(v2[3]<<16); x[7]=__uint_as_float(v1[3]&0xffff0000u)-lamf*__uint_as_float(v2[3]&0xffff0000u);
        float ss=(x[0]*x[0]+x[1]*x[1])+(x[2]*x[2]+x[3]*x[3])+(x[4]*x[4]+x[5]*x[5])+(x[6]*x[6]+x[7]*x[7]);
        ss+=__int_as_float(__builtin_amdgcn_update_dpp(0,__float_as_int(ss),0x128,0xf,0xf,false)); ss+=__int_as_float(__builtin_amdgcn_update_dpp(0,__float_as_int(ss),0x124,0xf,0xf,false));
        ss+=__int_as_float(__builtin_amdgcn_update_dpp(0,__float_as_int(ss),0x122,0xf,0xf,false)); ss+=__int_as_float(__builtin_amdgcn_update_dpp(0,__float_as_int(ss),0x121,0xf,0xf,false));
        const float rs=__builtin_amdgcn_rsqf(ss*(1.0f/128.0f)+1e-5f)*oscale;
        u32x4 w; w[0]=cvtpk_s(x[0]*gA.x*rs,x[1]*gA.y*rs); w[1]=cvtpk_s(x[2]*gA.z*rs,x[3]*gA.w*rs); w[2]=cvtpk_s(x[4]*gB.x*rs,x[5]*gB.y*rs); w[3]=cvtpk_s(x[6]*gB.z*rs,x[7]*gB.w*rs);
        *(u32x4*)(OCw+(long)row*DM+ch*8)=w; }
    } }
  asm volatile("s_waitcnt lgkmcnt(0)\n\ts_barrier":::"memory");
  #undef DMA_K
  #undef DMA_V
  #undef CMASK
  #undef START
  #undef RESC
  #undef ROT
}
constexpr int ATTN_LDS_BYTES=LDS_BYTES;
#undef SBAR
#undef WAIT_BAR
}
#ifndef STAGGER_ON
#define STAGGER_ON 0
#endif
#ifndef STAGGER_OUT
#define STAGGER_OUT 600
#endif
#ifndef STAGGER_DOWN
#define STAGGER_DOWN 1400
#endif
#ifndef PG8_ALIGN_EPI
#define PG8_ALIGN_EPI true
#endif
#ifndef PG8_SP2
#define PG8_SP2 true
#endif
namespace cg = cooperative_groups;
constexpr int NWAVES = 8;
constexpr int BATCH = 32, SEQ = 2048, D = 1024, M = BATCH * SEQ, DFF = 2816, GW = 1536;
constexpr size_t MiB = 1u << 20;
constexpr size_t WS_W_ATT_IN = 1 * MiB, WS_W_ATT_OUT = 13 * MiB, WS_W_G_IN = 17 * MiB, WS_W_G_OUT = 23 * MiB, WS_W_C_IN = 26 * MiB, WS_W_C_OUT = 32 * MiB, WS_W_GU = 34 * MiB, WS_W_DN = 78 * MiB, WS_WSB = 100 * MiB;
constexpr size_t WS_ROPE = 101 * MiB, WS_SSQ = 117 * MiB, WS_VSTAT = 121 * MiB, WS_XB = 133 * MiB, WS_ARENA = 261 * MiB, WS_END = 901 * MiB;
constexpr size_t AR_Q = 0, AR_K = 128 * MiB, AR_V = 256 * MiB, AR_O = 384 * MiB;
constexpr size_t AR_U = 0, AR_GV = 192 * MiB, AR_UV = 384 * MiB;
constexpr size_t AR_GB = 0, AR_HC = 128 * MiB, AR_Y = 256 * MiB;
constexpr size_t AR_H = 0;
constexpr int LDS_BYTES = 147456;

#define GAS __attribute__((address_space(1)))
#define LAS __attribute__((address_space(3)))
typedef unsigned short bf16;
typedef unsigned v4u __attribute__((ext_vector_type(4)));
typedef unsigned v2u __attribute__((ext_vector_type(2)));
typedef float f32x4 __attribute__((ext_vector_type(4)));
typedef float f32x2 __attribute__((ext_vector_type(2)));
typedef short bf16x8 __attribute__((ext_vector_type(8)));
typedef short s16x4 __attribute__((ext_vector_type(4)));
#define LDS_WAIT() asm volatile("s_waitcnt lgkmcnt(0)" ::: "memory")
#define VM_WAIT() asm volatile("s_waitcnt vmcnt(0)" ::: "memory")
__device__ __forceinline__ unsigned f2bf(float f) { unsigned u = __builtin_bit_cast(unsigned, f); return (u + 0x7fffu + ((u >> 16) & 1u)) >> 16; }
__device__ __forceinline__ unsigned pk2(float lo, float hi) { return f2bf(lo) | (f2bf(hi) << 16); }
__device__ __forceinline__ float bflo(unsigned w) { return __uint_as_float(w << 16); }
__device__ __forceinline__ float bfhi(unsigned w) { return __uint_as_float(w & 0xffff0000u); }
__device__ __forceinline__ float wave_sum(float v) {
    v += __int_as_float(__builtin_amdgcn_update_dpp(0, __float_as_int(v), 0x128, 0xf, 0xf, false)); v += __int_as_float(__builtin_amdgcn_update_dpp(0, __float_as_int(v), 0x124, 0xf, 0xf, false));
    v += __int_as_float(__builtin_amdgcn_update_dpp(0, __float_as_int(v), 0x122, 0xf, 0xf, false)); v += __int_as_float(__builtin_amdgcn_update_dpp(0, __float_as_int(v), 0x121, 0xf, 0xf, false));
    { const auto a = __builtin_amdgcn_permlane16_swap(__float_as_uint(v), __float_as_uint(v), false, false); v = __uint_as_float(a[0]) + __uint_as_float(a[1]); }
    { const auto b = __builtin_amdgcn_permlane32_swap(__float_as_uint(v), __float_as_uint(v), false, false); v = __uint_as_float(b[0]) + __uint_as_float(b[1]); }
    return v;
}

struct Params { const void* in[21]; float* out; unsigned char* ws; float lam0, lam1; };

__device__ __forceinline__ void p0_item(const float* W, int K, int N, bf16* WT, const float* gain, int kind, LAS float* scr, int item, int lane) {
    const int nblk = N / 32, kb = item / nblk, nb = item % nblk, k0 = 64 * kb, n0 = 32 * nb;
    int d0 = n0;
    if (kind == 1) { if (n0 < 2048) { const int part = n0 >> 10, head = (n0 >> 6) & 15, half = (n0 >> 5) & 1; d0 = (part * 4 + (head >> 2)) * 256 + half * 128 + (head & 3) * 32; } }
    else if (kind == 2) { if (n0 < 2816) d0 = (n0 >> 7) * 256 + (n0 & 127); else { const int j = n0 - 2816; d0 = (j >> 7) * 256 + 128 + (j & 127); } }
    else if (kind == 3) { if (n0 >= 2048) { const int j = n0 - 2048; d0 = 1024 + (j >> 7) * 256 + 128 + (j & 127); } else if (n0 >= 1024) { const int j = n0 - 1024; d0 = 1024 + (j >> 7) * 256 + (j & 127); } }
    f32x4 wv[8];
#pragma unroll
    for (int i = 0; i < 8; ++i) { const int kk = 8 * i + (lane >> 3); wv[i] = *(const f32x4*)(W + (size_t)(k0 + kk) * N + n0 + (lane & 7) * 4); }
#pragma unroll
    for (int i = 0; i < 8; ++i) { const int kk = 8 * i + (lane >> 3); const float gk = gain ? gain[k0 + kk] : 1.0f; LAS float* d = scr + kk * 33 + (lane & 7) * 4;
        d[0] = wv[i][0] * gk; d[1] = wv[i][1] * gk; d[2] = wv[i][2] * gk; d[3] = wv[i][3] * gk; }
    LDS_WAIT(); asm volatile("" ::: "memory");
    const int c = lane & 7;
#pragma unroll
    for (int j = 0; j < 4; ++j) { const int n = (lane >> 3) + 8 * j; const LAS float* s = scr + (8 * c) * 33 + n;
        v4u o; o.x = pk2(s[0 * 33], s[1 * 33]); o.y = pk2(s[2 * 33], s[3 * 33]); o.z = pk2(s[4 * 33], s[5 * 33]); o.w = pk2(s[6 * 33], s[7 * 33]);
        *(v4u*)(WT + (size_t)(d0 + n) * K + k0 + 8 * c) = o; }
    LDS_WAIT(); asm volatile("" ::: "memory");
}

typedef const __attribute__((address_space(4))) unsigned char* kaptr_t;
#define KIN(k) ((const float*)(const float __attribute__((address_space(1)))*)(*(const unsigned long long __attribute__((address_space(4)))*)(ka + 8 * (k))))
#define KOUT ((float*)(float __attribute__((address_space(1)))*)(*(const unsigned long long __attribute__((address_space(4)))*)(ka + 168)))
#define KWS ((unsigned char*)(unsigned char __attribute__((address_space(1)))*)(*(const unsigned long long __attribute__((address_space(4)))*)(ka + 176)))
#define KLAM(jj) (*(const float __attribute__((address_space(4)))*)(ka + 184 + 4 * (jj)))
#define LAUNDER() do { asm volatile("" : "+s"(ka)); asm volatile("" : "+v"(tid)); tid &= 511; } while (0)
#define WSPTRS() unsigned char* const ws = KWS; bf16* const XB = (bf16*)(ws + WS_XB); float* const SSQ = (float*)(ws + WS_SSQ); unsigned char* const AR = ws + WS_ARENA; (void)XB; (void)SSQ; (void)AR

#define XB_TMO      128
#define XB_XCNT(j)  (256  + 64 * (j))
#define XB_XSUB(j)  (1280 + 64 * (j))
#define XB_XGEN(j)  (2304 + 64 * (j))
#define XB_TOP      3328
#define XB_TOPGEN   3392
#define XCD_BAR_WORDS 3456
#define XB_SPIN_CAP (1u << 18)

__device__ __forceinline__ unsigned xb_ld(unsigned* p)              { return __hip_atomic_load(p, __ATOMIC_RELAXED, __HIP_MEMORY_SCOPE_AGENT); }
__device__ __forceinline__ unsigned xb_add(unsigned* p, unsigned v) { return __hip_atomic_fetch_add(p, v, __ATOMIC_RELAXED, __HIP_MEMORY_SCOPE_AGENT); }
__device__ __forceinline__ unsigned xb_xcc_id() { return (unsigned)__builtin_amdgcn_s_getreg((3 << 11) | 20) & 0xFu; }
#define XB_SPIN(cond, bar) do { unsigned _sp = 0; while (cond) { __builtin_amdgcn_s_sleep(1); \
    if ((++_sp & 255u) == 0u) { if (xb_ld(&(bar)[XB_TMO])) break; if (_sp > XB_SPIN_CAP) { atomicAdd(&(bar)[XB_TMO], 1u); break; } } } } while (0)

struct XcdBarrier {
    unsigned* bar; unsigned x;
    volatile LAS unsigned* st;
};

__device__ __forceinline__ XcdBarrier xcd_barrier_post(unsigned* bar, volatile LAS unsigned* st) {
    XcdBarrier b; b.bar = bar; b.x = xb_xcc_id(); b.st = st;
    if (threadIdx.x == 0) (void)xb_add(&bar[XB_XCNT(b.x)], 1u);
    return b;
}
__device__ __forceinline__ void xcd_barrier_complete(unsigned* bar, unsigned x, unsigned& nloc, unsigned& nx) {
    const unsigned G = gridDim.x * gridDim.y * gridDim.z;
    unsigned sum, cnt, mine, sp = 0u;
    for (;;) {
        sum = 0u; cnt = 0u; mine = 0u;
#pragma unroll
        for (unsigned j = 0; j < 16; ++j) { const unsigned c = xb_ld(&bar[XB_XCNT(j)]); sum += c; cnt += (c > 0u) ? 1u : 0u; mine = (j == x) ? c : mine; }
        if (sum == G) break;
        __builtin_amdgcn_s_sleep(1);
        if ((++sp & 255u) == 0u) { if (xb_ld(&bar[XB_TMO])) break; if (sp > XB_SPIN_CAP) { atomicAdd(&bar[XB_TMO], 1u); break; } }
    }
    nloc = mine > 0u ? mine : 1u; nx = cnt > 0u ? cnt : 1u;
}

__device__ __forceinline__ void xcd_barrier(const XcdBarrier& b) {
    asm volatile("s_waitcnt vmcnt(0)" ::: "memory");
    __syncthreads();
    if (threadIdx.x == 0) {
        unsigned* bar = b.bar;
        __builtin_amdgcn_s_waitcnt(0);
        unsigned nloc = b.st[0], nx = b.st[1];
        if (nloc == 0u) { xcd_barrier_complete(bar, b.x, nloc, nx); b.st[0] = nloc; b.st[1] = nx; }
        const unsigned old = xb_add(&bar[XB_XSUB(b.x)], 1u);
        const unsigned gen = old / nloc;
        if (old + 1u == (gen + 1u) * nloc) {
            __builtin_amdgcn_fence(__ATOMIC_RELEASE, "agent");
            asm volatile("s_waitcnt vmcnt(0)" ::: "memory");
            const unsigned og = xb_add(&bar[XB_TOP], 1u);
            const unsigned tg = og / nx;
            if (og + 1u == (tg + 1u) * nx) xb_add(&bar[XB_TOPGEN], 1u);
            else XB_SPIN(xb_ld(&bar[XB_TOPGEN]) == tg, bar);
            __builtin_amdgcn_fence(__ATOMIC_ACQUIRE, "agent");
            xb_add(&bar[XB_XGEN(b.x)], 1u);
            asm volatile("s_waitcnt vmcnt(0)" ::: "memory");
        } else {
            XB_SPIN(xb_ld(&bar[XB_XGEN(b.x)]) == gen, bar);
            __builtin_amdgcn_fence(__ATOMIC_ACQUIRE, "agent");
            asm volatile("s_waitcnt vmcnt(0)" ::: "memory");
        }
    }
    __syncthreads();
}

__device__ __forceinline__ void light_step(const int step, kaptr_t& ka, int& tid, LAS unsigned char* const L, const int G, const int bx, const int vcu) {
        const int layer = step / 5, stage = step % 5, kind = layer % 3, j = layer / 3;
        LAUNDER(); WSPTRS();
        const int lane = tid & 63, wave = __builtin_amdgcn_readfirstlane(tid >> 6); (void)lane; (void)wave;
        if (stage != 1) {
            pg8::Gemm g; pg8::EpiGen E;
            float* const out = KOUT;
            g.M = M; E.ssq = SSQ; E.eps = 1e-6f; E.o0 = nullptr; E.o1 = nullptr; E.o2 = nullptr; E.pos = (const int*)KIN(1); E.bias = KIN(10); E.vstat = (pg8::f32x2e*)(ws + WS_VSTAT); E.xout = nullptr; E.xb = XB;
            if (stage == 0) {
                g.A = XB; g.K = 1024; g.N = 3072;
                if (kind == 0) { g.Bt = (const bf16*)(ws + WS_W_ATT_IN) + (size_t)j * 3145728; E.mode = 0; E.o0 = (bf16*)(AR + AR_Q); E.o1 = (bf16*)(AR + AR_K); E.o2 = (bf16*)(AR + AR_V); }
                else if (kind == 1) { g.Bt = (const bf16*)(ws + WS_W_G_IN); E.mode = 1; E.o0 = (bf16*)(AR + AR_U); E.o1 = (bf16*)(AR + AR_GV); }
                else { g.Bt = (const bf16*)(ws + WS_W_C_IN); E.mode = 2; E.o0 = (bf16*)(AR + AR_GB); E.o1 = (bf16*)(AR + AR_HC); }
            } else if (stage == 2) {
                g.N = 1024; E.mode = 3; E.o0 = XB;
                if (kind == 0) { g.A = (const bf16*)(AR + AR_Q); g.Bt = (const bf16*)(ws + WS_W_ATT_OUT) + (size_t)j * 1048576; g.K = 1024; }
                else if (kind == 1) { g.A = (const bf16*)(AR + AR_UV); g.Bt = (const bf16*)(ws + WS_W_G_OUT); g.K = 1536; }
                else { g.A = (const bf16*)(AR + AR_Y); g.Bt = (const bf16*)(ws + WS_W_C_OUT); g.K = 1024; }
            } else if (stage == 3) {
                g.A = XB; g.Bt = (const bf16*)(ws + WS_W_GU) + (size_t)layer * 5767168; g.N = 5632; g.K = 1024; E.mode = 4; E.o0 = (bf16*)(AR + AR_H);
            } else {
                g.A = (const bf16*)(AR + AR_H); g.Bt = (const bf16*)(ws + WS_W_DN) + (size_t)layer * 2883584; g.N = 1024; g.K = 2816; E.mode = 3; E.o0 = (layer == 3) ? nullptr : XB; E.xout = (layer == 3) ? out : nullptr;
            }
            pg8::StaticOrder S; S.init(g.M, g.N, G, bx);
            if (E.mode == 3 && STAGGER_ON) {
                const unsigned long long dl = (unsigned long long)(bx >> 6) * (stage == 2 ? STAGGER_OUT : STAGGER_DOWN);
                const unsigned long long t0_ = __builtin_amdgcn_s_memrealtime(); while (__builtin_amdgcn_s_memrealtime() - t0_ < dl) __builtin_amdgcn_s_sleep(4);
            }
            pg8::gemm_phase<pg8::EpiGen, pg8::StaticOrder, PG8_ALIGN_EPI, PG8_SP2>(L, g, S, E, tid);
        } else if (kind == 1) {
            const bf16* U = (const bf16*)(AR + AR_U); const bf16* GV = (const bf16*)(AR + AR_GV); bf16* UV = (bf16*)(AR + AR_UV);
            constexpr int SP_RS = 784;
            LAS f32x2* stat = (LAS f32x2*)(L + 128 * SP_RS); const f32x2* VSTAT = (const f32x2*)(ws + WS_VSTAT); const bf16* WSB = (const bf16*)(ws + WS_WSB);
            const float* gmlp_ln_g = KIN(11); const float* gmlp_ln_b = KIN(12); const float* gmlp_b_s = KIN(14);
            const int fr = lane & 15, fq = lane >> 4;
            const int cgp = tid % 48, rsl = tid / 48;
            for (int unit = vcu; unit < 2048; unit += G) {
                const int chunk = unit >> 2, gp = unit & 3; const size_t row0 = (size_t)chunk * 128;
                const int c = gp * 384 + cgp * 8;
                const f32x4 ga = *(const f32x4*)(gmlp_ln_g + c), gb = *(const f32x4*)(gmlp_ln_g + c + 4), ba = *(const f32x4*)(gmlp_ln_b + c), bb = *(const f32x4*)(gmlp_ln_b + c + 4);
                __syncthreads();
                if (tid < 128) {
                    const f32x4* ps = (const f32x4*)(VSTAT + (row0 + tid) * 24); float s1 = 0.f, s2 = 0.f;
#pragma unroll
                    for (int i = 0; i < 12; ++i) { const f32x4 q = ps[i]; s1 += q[0] + q[2]; s2 += q[1] + q[3]; }
                    const float mean = s1 * (1.0f / 1536.0f); const float var = fmaxf(s2 * (1.0f / 1536.0f) - mean * mean, 0.f);
                    stat[tid] = (f32x2){mean, __builtin_amdgcn_rsqf(var + 1e-5f)};
                }
                v4u raw[13];
#pragma unroll
                for (int i = 0; i < 13; ++i) { const int r = rsl + 10 * i; raw[i] = *(const v4u*)(GV + (row0 + (r < 128 ? r : 127)) * 1536 + c); }
                __syncthreads();
#pragma unroll
                for (int i = 0; i < 13; ++i) {
                    const int r = rsl + 10 * i;
                    if (tid < 480 && r < 128) {
                        const f32x2 st = stat[r];
                        f32x4 v0 = (f32x4){bflo(raw[i].x), bfhi(raw[i].x), bflo(raw[i].y), bfhi(raw[i].y)}, v1 = (f32x4){bflo(raw[i].z), bfhi(raw[i].z), bflo(raw[i].w), bfhi(raw[i].w)};
                        v0 = (v0 - st.x) * st.y * ga + ba; v1 = (v1 - st.x) * st.y * gb + bb;
                        *(LAS v4u*)(L + r * SP_RS + cgp * 16) = (v4u){pk2(v0[0], v0[1]), pk2(v0[2], v0[3]), pk2(v1[0], v1[1]), pk2(v1[2], v1[3])};
                    }
                }
                __syncthreads();
                const int t = 16 * wave + fr; const int nk = (wave >> 1) + 1;
                for (int gi = 0; gi < 2; ++gi) {
                    const int gg = 2 * gp + gi;
                    f32x4 acc[12];
#pragma unroll
                    for (int n = 0; n < 12; ++n) acc[n] = (f32x4){0.f, 0.f, 0.f, 0.f};
                    for (int kk = 0; kk < nk; ++kk) {
                        const bf16x8 wsf = *(const bf16x8*)(WSB + ((size_t)gg * 128 + t) * 128 + 32 * kk + 8 * fq);
                        const LAS unsigned char* tb = L + (32 * kk + 8 * fq + ((lane >> 2) & 3)) * SP_RS + gi * 384 + (lane & 3) * 8;
#pragma unroll
                        for (int n = 0; n < 12; ++n) {
                            const s16x4 lo = __builtin_bit_cast(s16x4, __builtin_amdgcn_ds_read_tr16_b64_v4i16((LAS s16x4*)(tb + n * 32)));
                            const s16x4 hi = __builtin_bit_cast(s16x4, __builtin_amdgcn_ds_read_tr16_b64_v4i16((LAS s16x4*)(tb + n * 32 + 4 * SP_RS)));
                            const bf16x8 vf = (bf16x8){lo[0], lo[1], lo[2], lo[3], hi[0], hi[1], hi[2], hi[3]};
                            acc[n] = __builtin_amdgcn_mfma_f32_16x16x32_bf16(vf, wsf, acc[n], 0, 0, 0);
                        }
                    }
                    const float bs = gmlp_b_s[gg * 128 + t];
                    v2u uv_[12];
#pragma unroll
                    for (int n = 0; n < 12; ++n) uv_[n] = *(const v2u*)(U + (row0 + t) * 1536 + gg * 192 + 16 * n + 4 * fq);
#pragma unroll
                    for (int n = 0; n < 12; ++n) {
                        const size_t o = (row0 + t) * 1536 + gg * 192 + 16 * n + 4 * fq;
                        const v2u uu = uv_[n];
                        const f32x4 sv = acc[n] + bs;
                        *(v2u*)(UV + o) = (v2u){pk2(bflo(uu.x) * sv[0], bfhi(uu.x) * sv[1]), pk2(bflo(uu.y) * sv[2], bfhi(uu.y) * sv[3])};
                    }
                }
            }
        } else {
            const float* conv_w = KIN(17);
            const bf16* GBp = (const bf16*)(AR + AR_GB); const bf16* HC = (const bf16*)(AR + AR_HC); bf16* Y = (bf16*)(AR + AR_Y);
            const int gt = vcu * (NWAVES * 64) + tid, NGT = G * NWAVES * 64;
            for (int it = gt; it < (M / 8) * 128; it += NGT) {
                const int cgp = it & 127, rb = it >> 7, c = cgp * 8; const size_t t0 = (size_t)rb * 8;
                const f32x4 w0a = *(const f32x4*)(conv_w + c), w0b = *(const f32x4*)(conv_w + c + 4), w1a = *(const f32x4*)(conv_w + 1024 + c), w1b = *(const f32x4*)(conv_w + 1024 + c + 4), w2a = *(const f32x4*)(conv_w + 2048 + c), w2b = *(const f32x4*)(conv_w + 2048 + c + 4);
                f32x4 m2a = (f32x4){0.f, 0.f, 0.f, 0.f}, m2b = m2a, m1a = m2a, m1b = m2a;
                if ((t0 & (SEQ - 1)) != 0) {
                    const v4u r2 = *(const v4u*)(HC + (t0 - 2) * 1024 + c), r1 = *(const v4u*)(HC + (t0 - 1) * 1024 + c);
                    m2a = (f32x4){bflo(r2.x), bfhi(r2.x), bflo(r2.y), bfhi(r2.y)}; m2b = (f32x4){bflo(r2.z), bfhi(r2.z), bflo(r2.w), bfhi(r2.w)};
                    m1a = (f32x4){bflo(r1.x), bfhi(r1.x), bflo(r1.y), bfhi(r1.y)}; m1b = (f32x4){bflo(r1.z), bfhi(r1.z), bflo(r1.w), bfhi(r1.w)};
                }
                v4u hrv[8], grv[8];
#pragma unroll
                for (int r = 0; r < 8; ++r) { hrv[r] = *(const v4u*)(HC + (t0 + r) * 1024 + c); grv[r] = *(const v4u*)(GBp + (t0 + r) * 1024 + c); }
#pragma unroll
                for (int r = 0; r < 8; ++r) {
                    const v4u hr = hrv[r], gr = grv[r];
                    const f32x4 ha = (f32x4){bflo(hr.x), bfhi(hr.x), bflo(hr.y), bfhi(hr.y)}, hb = (f32x4){bflo(hr.z), bfhi(hr.z), bflo(hr.w), bfhi(hr.w)};
                    const f32x4 ga = (f32x4){bflo(gr.x), bfhi(gr.x), bflo(gr.y), bfhi(gr.y)}, gb = (f32x4){bflo(gr.z), bfhi(gr.z), bflo(gr.w), bfhi(gr.w)};
                    const f32x4 ya = ga * (w0a * m2a + w1a * m1a + w2a * ha), yb = gb * (w0b * m2b + w1b * m1b + w2b * hb);
                    *(v4u*)(Y + (t0 + r) * 1024 + c) = (v4u){pk2(ya[0], ya[1]), pk2(ya[2], ya[3]), pk2(yb[0], yb[1]), pk2(yb[2], yb[3])};
                    m2a = m1a; m2b = m1b; m1a = ha; m1b = hb;
                }
            }
        }
}

__device__ __forceinline__ void attn_step(const int j, kaptr_t& ka, int& tid, char* const ldsg, const int G, const int vcu) {
        LAUNDER(); WSPTRS();
        {
            const attn_body::bf16* Q = (const attn_body::bf16*)(AR + AR_Q); const attn_body::bf16* Kp = (const attn_body::bf16*)(AR + AR_K); const attn_body::bf16* Vp = (const attn_body::bf16*)(AR + AR_V);
            attn_body::bf16* O = (attn_body::bf16*)(AR + AR_O);
            const float lam_init = KLAM(j); const float* attn_lambda = KIN(6); const float* attn_subln = KIN(7);
            const float* lam = attn_lambda + j * 256; const int lane0 = tid & 63;
            const float la = wave_sum(lam[lane0] * lam[64 + lane0]), lb = wave_sum(lam[128 + lane0] * lam[192 + lane0]);
            const unsigned lamf_bits = __builtin_amdgcn_readfirstlane(__float_as_uint(__expf(la) - __expf(lb) + lam_init)), oscale_bits = __builtin_amdgcn_readfirstlane(__float_as_uint(1.0f - lam_init));
            for (int bh = vcu; bh < BATCH * 8; bh += G) {
                const int b = bh >> 3, h = bh & 7;
                for (int ui = 0; ui < 16; ++ui) {
                    const int qb = 7 - (ui >> 1), map = ui & 1;
                    attn_body::attn_unit<8>(b, 2 * h + map, h * 128, h * 256 + map * 128, qb, Q, Kp, Vp, O, ldsg, tid, map == 1, lamf_bits, oscale_bits, attn_subln + j * 128, (attn_body::bf16*)(AR + AR_Q), h * 128);
                }
            }
        }
}

#ifndef PROBE_MASK
#define PROBE_MASK 0u
#endif
__global__ void __launch_bounds__(NWAVES * 64, 2) trunk_fwd(Params p) {
    extern __shared__ __attribute__((aligned(16))) unsigned char lds[];
    cg::grid_group grid = cg::this_grid();
    LAS unsigned char* const L = (LAS unsigned char*)lds;
    const int G = gridDim.x; const int bx = blockIdx.x; const int vcu = (G % 8 == 0) ? (bx % 8) * (G / 8) + bx / 8 : bx;
    kaptr_t ka = (kaptr_t)__builtin_amdgcn_kernarg_segment_ptr();
    int tid = threadIdx.x;

#if PROBE_MASK
    unsigned long long* const TS = (unsigned long long*)KWS;
#define STAMP(k) do { if (blockIdx.x == 0 && threadIdx.x == 0) TS[(k)] = __builtin_amdgcn_s_memrealtime(); } while (0)
#else
#define STAMP(k) do { } while (0)
#endif
    STAMP(0);
#ifdef PROBE_DELAY
    { const unsigned long long t0_ = __builtin_amdgcn_s_memrealtime(); while (__builtin_amdgcn_s_memrealtime() - t0_ < (unsigned long long)PROBE_DELAY) __builtin_amdgcn_s_sleep(8); }
#endif
    {
        LAUNDER(); WSPTRS();
        const int lane = tid & 63, wave = __builtin_amdgcn_readfirstlane(tid >> 6);
        const float* x_in = KIN(0); const float* mix_norm = KIN(2); const float* ffn_norm = KIN(3);
        const float* attn_w_in = KIN(5); const float* attn_w_out = KIN(8); const float* gmlp_w_in = KIN(9); const float* gmlp_w_s = KIN(13); const float* gmlp_w_out = KIN(15);
        const float* conv_w_in = KIN(16); const float* conv_w_out = KIN(18); const float* ffn_w_gu = KIN(19); const float* ffn_w_dn = KIN(20);
        bf16* const W_ATT_IN = (bf16*)(ws + WS_W_ATT_IN); bf16* const W_ATT_OUT = (bf16*)(ws + WS_W_ATT_OUT); bf16* const W_G_IN = (bf16*)(ws + WS_W_G_IN); bf16* const W_G_OUT = (bf16*)(ws + WS_W_G_OUT);
        bf16* const W_C_IN = (bf16*)(ws + WS_W_C_IN); bf16* const W_C_OUT = (bf16*)(ws + WS_W_C_OUT); bf16* const W_GU = (bf16*)(ws + WS_W_GU); bf16* const W_DN = (bf16*)(ws + WS_W_DN); bf16* const WSB = (bf16*)(ws + WS_WSB);
        LAS float* scr = (LAS float*)(L + wave * 16384);
        const int gw = vcu * NWAVES + wave, NGW = G * NWAVES;
        constexpr int I_AIN = 16 * 96, I_AOUT = 16 * 32, I_GOUT = 24 * 32, I_GU = 16 * 176, I_DN = 44 * 32;
        constexpr int NITEMS = 2 * I_AIN + 2 * I_AOUT + I_AIN + I_GOUT + I_AIN + I_AOUT + 4 * I_GU + 4 * I_DN;
        for (int it = gw; it < NITEMS; it += NGW) {
            int r = it;
            if (r < 2 * I_AIN) { const int j = r / I_AIN; p0_item(attn_w_in + (size_t)j * 3145728, 1024, 3072, W_ATT_IN + (size_t)j * 3145728, mix_norm + (j ? 3 : 0) * 1024, 1, scr, r % I_AIN, lane); continue; } r -= 2 * I_AIN;
            if (r < 2 * I_AOUT) { const int j = r / I_AOUT; p0_item(attn_w_out + (size_t)j * 1048576, 1024, 1024, W_ATT_OUT + (size_t)j * 1048576, nullptr, 0, scr, r % I_AOUT, lane); continue; } r -= 2 * I_AOUT;
            if (r < I_AIN) { p0_item(gmlp_w_in, 1024, 3072, W_G_IN, mix_norm + 1024, 0, scr, r, lane); continue; } r -= I_AIN;
            if (r < I_GOUT) { p0_item(gmlp_w_out, 1536, 1024, W_G_OUT, nullptr, 0, scr, r, lane); continue; } r -= I_GOUT;
            if (r < I_AIN) { p0_item(conv_w_in, 1024, 3072, W_C_IN, mix_norm + 2048, 3, scr, r, lane); continue; } r -= I_AIN;
            if (r < I_AOUT) { p0_item(conv_w_out, 1024, 1024, W_C_OUT, nullptr, 0, scr, r, lane); continue; } r -= I_AOUT;
            if (r < 4 * I_GU) { const int j = r / I_GU; p0_item(ffn_w_gu + (size_t)j * 5767168, 1024, 5632, W_GU + (size_t)j * 5767168, ffn_norm + j * 1024, 2, scr, r % I_GU, lane); continue; } r -= 4 * I_GU;
            { const int j = r / I_DN; p0_item(ffn_w_dn + (size_t)j * 2883584, 2816, 1024, W_DN + (size_t)j * 2883584, nullptr, 0, scr, r % I_DN, lane); }
        }
        const int gt = vcu * (NWAVES * 64) + tid, NGT = G * NWAVES * 64;
        for (int i = gt; i < 8 * 128 * 128; i += NGT) { const int s = i & 127, t = (i >> 7) & 127; WSB[i] = (s <= t) ? (bf16)f2bf(gmlp_w_s[i]) : (bf16)0; }
        for (int m0 = gw * 4; m0 < M; m0 += NGW * 4) {
            f32x4 v[4][4]; float s[4];
#pragma unroll
            for (int r = 0; r < 4; ++r) { const f32x4* xr = (const f32x4*)(x_in + (size_t)(m0 + r) * D) + lane;
#pragma unroll
                for (int j = 0; j < 4; ++j) v[r][j] = xr[64 * j]; }
#pragma unroll
            for (int r = 0; r < 4; ++r) { float a = 0.f;
#pragma unroll
                for (int j = 0; j < 4; ++j) a += (v[r][j][0] * v[r][j][0] + v[r][j][1] * v[r][j][1]) + (v[r][j][2] * v[r][j][2] + v[r][j][3] * v[r][j][3]);
                s[r] = wave_sum(a);
                v2u* o8 = (v2u*)(XB + (size_t)(m0 + r) * D) + lane;
#pragma unroll
                for (int j = 0; j < 4; ++j) o8[64 * j] = (v2u){pk2(v[r][j][0], v[r][j][1]), pk2(v[r][j][2], v[r][j][3])};
                if (lane < 16) SSQ[(size_t)(m0 + r) * 16 + lane] = (lane == 0) ? s[r] : 0.f; }
        }
    }
    unsigned* const barw = (unsigned*)(KWS + 65536);
    if (blockIdx.x == 0) for (int i_ = threadIdx.x; i_ < XCD_BAR_WORDS; i_ += NWAVES * 64) barw[i_] = 0u;
    volatile LAS unsigned* const bst = (volatile LAS unsigned*)(L + LDS_BYTES - 16);
    if (threadIdx.x < 2) bst[threadIdx.x] = 0u;
    grid.sync(); STAMP(1);
    if (threadIdx.x == 0) {
        const unsigned xcc = xb_xcc_id(); const unsigned idx = xb_add(&barw[XB_XCNT(xcc)], 1u);
        unsigned sum, off, rank, nz, sp = 0u; bool even;
        for (;;) {
            sum = 0u; off = 0u; rank = 0u; nz = 0u; even = true;
#pragma unroll
            for (unsigned j = 0; j < 16; ++j) { const unsigned c = xb_ld(&barw[XB_XCNT(j)]); sum += c; if (j < xcc) { off += c; rank += (c > 0u) ? 1u : 0u; } nz += (c > 0u) ? 1u : 0u; if (c != 0u && c * 8u != (unsigned)G) even = false; }
            if (sum == (unsigned)G) break;
            __builtin_amdgcn_s_sleep(1);
            if (++sp > XB_SPIN_CAP) { even = false; off = (unsigned)blockIdx.x - idx; break; }
        }
        const unsigned vce_ = off + idx;
        const unsigned bxe_ = (even && nz == 8u) ? (idx * 8u + rank) : vce_;
        bst[2] = bxe_; bst[3] = vce_;
    }
    __syncthreads();
    const int bxe = __builtin_amdgcn_readfirstlane((int)bst[2]), vce = __builtin_amdgcn_readfirstlane((int)bst[3]);
#define GSYNC() do { XcdBarrier b_; b_.bar = (unsigned*)(KWS + 65536); b_.x = xb_xcc_id(); b_.st = (volatile LAS unsigned*)(L + LDS_BYTES - 16); xcd_barrier(b_); } while (0)
#ifdef PROBE_NSYNC
    for (int i_ = 0; i_ < PROBE_NSYNC; ++i_) grid.sync();
#endif

#ifndef DBG_NO_LIGHT
    light_step(0, ka, tid, L, G, bxe, vce); GSYNC(); STAMP(2);
#endif
#ifndef DBG_NO_ATTN
    attn_step(0, ka, tid, (char*)lds, G, vce); GSYNC(); STAMP(3);
#endif
#ifndef DBG_NO_LIGHT
    for (int step = 2; step < 16; ++step) { light_step(step, ka, tid, L, G, bxe, vce); GSYNC(); STAMP(2 + step); }
#endif
#ifndef DBG_NO_ATTN2
    attn_step(1, ka, tid, (char*)lds, G, vce); GSYNC(); STAMP(18);
#endif
#ifndef DBG_NO_LIGHT
    for (int step = 17; step < 20; ++step) { light_step(step, ka, tid, L, G, bxe, vce); GSYNC(); STAMP(2 + step); }
#endif
#if PROBE_MASK
    grid.sync();
#endif

    {
        LAUNDER();
        const int lane = tid & 63, wave = __builtin_amdgcn_readfirstlane(tid >> 6); float* const out = KOUT; const float* final_norm = KIN(4);
        const int gw = vcu * NWAVES + wave, NGW = G * NWAVES;
        f32x4 gn[4];
#pragma unroll
        for (int jj = 0; jj < 4; ++jj) gn[jj] = *((const f32x4*)final_norm + lane + 64 * jj);
#if PROBE_MASK
        for (int m = M - 1 - gw; m >= 0; m -= NGW) {
            f32x4* xr = (f32x4*)(out + (size_t)m * D) + lane; f32x4 v[4]; float s = 0.f;
#pragma unroll
            for (int jj = 0; jj < 4; ++jj) { v[jj] = xr[64 * jj]; s += (v[jj][0] * v[jj][0] + v[jj][1] * v[jj][1]) + (v[jj][2] * v[jj][2] + v[jj][3] * v[jj][3]); }
            const float rs = __builtin_amdgcn_rsqf(wave_sum(s) * (1.0f / 1024.0f) + 1e-6f);
            if (m < 4096) {
                unsigned long long tt = 0;
                for (int k = 0; k < 21; ++k) if ((PROBE_MASK >> k) & 1u) tt += TS[k + 1] - TS[k];
                if ((PROBE_MASK >> 21) & 1u) tt += __builtin_amdgcn_s_memrealtime() - TS[21];
                if ((PROBE_MASK >> 22) & 1u) tt += TS[21] - TS[0];
                const float delta = sqrtf((float)tt * 0.01f * 0.25e-6f);
#pragma unroll
                for (int jj = 0; jj < 4; ++jj) { f32x4 o = v[jj] * rs * gn[jj]; o[0] += delta; o[1] -= delta; o[2] += delta; o[3] -= delta; xr[64 * jj] = o; }
            } else {
#pragma unroll
                for (int jj = 0; jj < 4; ++jj) xr[64 * jj] = v[jj] * rs * gn[jj];
            }
        }
#else
        for (int m0 = gw * 4; m0 < M; m0 += NGW * 4) {
            f32x4 v[4][4];
#pragma unroll
            for (int r = 0; r < 4; ++r) { const f32x4* xr = (const f32x4*)(out + (size_t)(m0 + r) * D) + lane;
#pragma unroll
                for (int jj = 0; jj < 4; ++jj) v[r][jj] = xr[64 * jj]; }
#pragma unroll
            for (int r = 0; r < 4; ++r) { float s = 0.f;
#pragma unroll
                for (int jj = 0; jj < 4; ++jj) s += (v[r][jj][0] * v[r][jj][0] + v[r][jj][1] * v[r][jj][1]) + (v[r][jj][2] * v[r][jj][2] + v[r][jj][3] * v[r][jj][3]);
                const float rs = __builtin_amdgcn_rsqf(wave_sum(s) * (1.0f / 1024.0f) + 1e-6f);
                f32x4* xw = (f32x4*)(out + (size_t)(m0 + r) * D) + lane;
#pragma unroll
                for (int jj = 0; jj < 4; ++jj) xw[64 * jj] = v[r][jj] * rs * gn[jj]; }
        }
#endif
    }
}

extern "C" void kernel_launch(void* const* d_in, const int* in_sizes, int n_in, void* d_out, int out_size, void* d_ws, size_t ws_size, hipStream_t stream) {
    static int grid = 0;
    if (grid == 0) {
        if (n_in != 21 || in_sizes[0] != M * D || out_size != M * D || ws_size < WS_END) { fprintf(stderr, "kernel_launch: unexpected shapes (n_in %d, in0 %d, out %d, ws %zu)\n", n_in, n_in > 0 ? in_sizes[0] : -1, out_size, ws_size); grid = -1; return; }
        int dev = 0, cus = 0, per_cu = 0;
        if (hipGetDevice(&dev) != hipSuccess || hipDeviceGetAttribute(&cus, hipDeviceAttributeMultiprocessorCount, dev) != hipSuccess) { grid = -1; return; }
        if (hipFuncSetAttribute((const void*)trunk_fwd, hipFuncAttributeMaxDynamicSharedMemorySize, LDS_BYTES) != hipSuccess) { fprintf(stderr, "kernel_launch: hipFuncSetAttribute failed\n"); grid = -1; return; }
        if (hipOccupancyMaxActiveBlocksPerMultiprocessor(&per_cu, (const void*)trunk_fwd, NWAVES * 64, LDS_BYTES) != hipSuccess || per_cu < 1) { fprintf(stderr, "kernel_launch: occupancy query says %d\n", per_cu); per_cu = 1; }
        (void)hipGetLastError();
        grid = cus;
    }
    if (grid < 0) return;
    Params p{};
    for (int i = 0; i < 21; ++i) p.in[i] = d_in[i];
    p.out = (float*)d_out; p.ws = (unsigned char*)d_ws;
    p.lam0 = (float)(0.8 - 0.6 * exp(-0.3 * 0.0)); p.lam1 = (float)(0.8 - 0.6 * exp(-0.3 * 3.0));
    void* args[] = {&p};
    const hipError_t e = hipLaunchCooperativeKernel((const void*)trunk_fwd, dim3(grid), dim3(NWAVES * 64), args, LDS_BYTES, stream);
    if (e != hipSuccess) fprintf(stderr, "kernel_launch: cooperative launch failed: %s (grid %d)\n", hipGetErrorString(e), grid);
}
```

```cpp
#include <hip/hip_runtime.h>
#include <hip/hip_cooperative_groups.h>
#include <cstdio>
#include <cstdint>
#include <cmath>
namespace pg8 {
#define PG8_LAS __attribute__((address_space(3)))
typedef unsigned short bf16_t;
typedef short bf16x8 __attribute__((ext_vector_type(8)));
typedef float f32x4 __attribute__((ext_vector_type(4)));
typedef unsigned u32x4 __attribute__((ext_vector_type(4)));
constexpr int BM = 256, BK = 64, HALF = 128, HTB = HALF * BK * 2  , STAGE_BYTES = 8 * HTB, NXCD = 8, WGM = 8;

__host__ __device__ __forceinline__ int lds_byte(int r, int c) { const int st = (r >> 4) * 2 + (c >> 5), rr = r & 15, cc = c & 31, ob = rr * 64 + cc * 2; return st * 1024 + (ob ^ (((ob >> 9) & 1) << 5)); }
__host__ __device__ __forceinline__ void stage_rc(int b, int& R, int& C) { const int st = b / 1024, sb = b % 1024, swz = sb ^ (((sb >> 9) & 1) << 5); R = (st >> 1) * 16 + swz / 64; C = (st & 1) * 32 + (swz % 64) / 2; }
__host__ __device__ __forceinline__ int perm32(int rho) { const int n = rho >> 4, i = rho & 15; return 8 * (i >> 2) + 4 * n + (i & 3); }

struct Unit { int pm, pn; };
struct Gemm { const bf16_t* A; const bf16_t* Bt; int M, N, K; };

struct StaticOrder {
    int nM, nN, nwg, G, c;
    __host__ __device__ void init(int M, int N, int G_, int c_) { nM = M / BM; nN = N / BM; nwg = nM * nN; G = G_; c = c_; }
    __host__ __device__ bool next(int i, Unit& u) const {
        const long L = (long)i * G + c; if (L >= nwg) return false;
        int wgid = (int)L; { const int q = nwg / NXCD, r = nwg % NXCD, xcd = wgid % NXCD, off = wgid / NXCD; wgid = (xcd < r ? xcd * (q + 1) : r * (q + 1) + (xcd - r) * q) + off; }
        const int nig = WGM * nN, gid = wgid / nig, fm = gid * WGM, gsz = (nM - fm) < WGM ? (nM - fm) : WGM;
        u.pm = fm + ((wgid % nig) % gsz); u.pn = (wgid % nig) / gsz; return true;
    }
    __device__ __forceinline__ void a_ready(const Unit&) const {}
    __device__ __forceinline__ void done(const Unit&) const {}
};
__device__ __forceinline__ unsigned cvt_pk_bf16(float lo, float hi) { unsigned r; asm volatile("v_cvt_pk_bf16_f32 %0, %1, %2" : "=v"(r) : "v"(lo), "v"(hi)); return r; }
typedef float f32x2 __attribute__((ext_vector_type(2)));
__device__ __forceinline__ f32x2 gelu_pk(f32x2 v) {
    const f32x2 av = __builtin_elementwise_abs(v), d = av * 0.2316418882f + 1.0f;
    f32x2 t; t.x = __builtin_amdgcn_rcpf(d.x); t.y = __builtin_amdgcn_rcpf(d.y);
    f32x2 q = t * 0.5307027145f + (-0.7265760135f); q = q * t + 0.7107068705f; q = q * t + (-0.142248368f); q = q * t + 0.127414796f; q = q * t;
    const f32x2 s = (v * v) * (-0.72134752044f);
    f32x2 e; e.x = __builtin_amdgcn_exp2f(s.x); e.y = __builtin_amdgcn_exp2f(s.y);
    const f32x2 m = v * (q * e), r = v - m;
    f32x2 o; o.x = v.x < 0.f ? m.x : r.x; o.y = v.y < 0.f ? m.y : r.y; return o;
}
constexpr float QK_C2 = 0.125f * 1.4426950408889634f;
typedef float f32x2e __attribute__((ext_vector_type(2)));
__device__ __forceinline__ u32x4 pack8(const f32x4 a, const f32x4 b) { u32x4 w; w.x = cvt_pk_bf16(a[0], a[1]); w.y = cvt_pk_bf16(a[2], a[3]); w.z = cvt_pk_bf16(b[0], b[1]); w.w = cvt_pk_bf16(b[2], b[3]); return w; }
__device__ __forceinline__ float quad_sum(float s) {
    { const auto a = __builtin_amdgcn_permlane16_swap(__float_as_uint(s), __float_as_uint(s), false, false); s = __uint_as_float(a[0]) + __uint_as_float(a[1]); }
    { const auto b = __builtin_amdgcn_permlane32_swap(__float_as_uint(s), __float_as_uint(s), false, false); s = __uint_as_float(b[0]) + __uint_as_float(b[1]); }
    return s; }
__device__ __forceinline__ void gelu8(f32x4& v0, f32x4& v1) {
    const f32x4 a0 = __builtin_elementwise_abs(v0), a1 = __builtin_elementwise_abs(v1), d0 = a0 * 0.2316418882f + 1.0f, d1 = a1 * 0.2316418882f + 1.0f;
    f32x4 t0, t1;
#pragma unroll
    for (int e = 0; e < 4; ++e) { t0[e] = __builtin_amdgcn_rcpf(d0[e]); t1[e] = __builtin_amdgcn_rcpf(d1[e]); }
    f32x4 q0 = t0 * 0.5307027145f + (-0.7265760135f), q1 = t1 * 0.5307027145f + (-0.7265760135f);
    q0 = q0 * t0 + 0.7107068705f; q1 = q1 * t1 + 0.7107068705f; q0 = q0 * t0 + (-0.142248368f); q1 = q1 * t1 + (-0.142248368f);
    q0 = q0 * t0 + 0.127414796f; q1 = q1 * t1 + 0.127414796f; q0 = q0 * t0; q1 = q1 * t1;
    const f32x4 s0 = (v0 * v0) * (-0.72134752044f), s1 = (v1 * v1) * (-0.72134752044f);
    f32x4 e0, e1;
#pragma unroll
    for (int e = 0; e < 4; ++e) { e0[e] = __builtin_amdgcn_exp2f(s0[e]); e1[e] = __builtin_amdgcn_exp2f(s1[e]); }
    const f32x4 m0 = v0 * (q0 * e0), m1 = v1 * (q1 * e1), r0 = v0 - m0, r1 = v1 - m1;
#pragma unroll
    for (int e = 0; e < 4; ++e) { const float x0 = v0[e], x1 = v1[e]; v0[e] = x0 < 0.f ? m0[e] : r0[e]; v1[e] = x1 < 0.f ? m1[e] : r1[e]; }
}
struct EpiGen {
    static constexpr bool PERM = true, AFTER_DRAIN = false;
    int mode;
    float* ssq;
    float eps;
    bf16_t *o0, *o1, *o2;
    const int* pos;
    const float* bias;
    f32x2e* vstat;
    float* xout; const bf16_t* xb;
    __device__ __forceinline__ float row_rstd(int row, int fq) const {
        const f32x4 p = *(const f32x4*)(ssq + (size_t)row * 16 + fq * 4);
        const float s = quad_sum((p[0] + p[1]) + (p[2] + p[3]));
        return __builtin_amdgcn_rsqf(s * (1.0f / 1024.0f) + eps);
    }
    __device__ __forceinline__ void operator()(const f32x4 (&acc)[2][2][4][2], const Unit& u, int wr, int wc, int fr, int fq) const {
        asm volatile("" : "+v"(fr), "+v"(fq));
        const int rowb = u.pm * BM + wr * 64 + fr, pn = u.pn;
        float rsv[2][4];
        if (mode != 3) { f32x4 pp[2][4];
#pragma unroll
            for (int ai = 0; ai < 2; ++ai)
#pragma unroll
                for (int m = 0; m < 4; ++m) pp[ai][m] = *(const f32x4*)(ssq + (size_t)(rowb + ai * HALF + m * 16) * 16 + fq * 4);
#pragma unroll
            for (int ai = 0; ai < 2; ++ai)
#pragma unroll
                for (int m = 0; m < 4; ++m) rsv[ai][m] = __builtin_amdgcn_rsqf(quad_sum((pp[ai][m][0] + pp[ai][m][1]) + (pp[ai][m][2] + pp[ai][m][3])) * (1.0f / 1024.0f) + eps); }
        if (mode == 3) {
            const int col0 = pn * BM + wc * 32 + 8 * fq;
            u32x4 xw[8][2];
#pragma unroll
            for (int k = 0; k < 4; ++k)
#pragma unroll
                for (int bj = 0; bj < 2; ++bj) xw[k][bj] = *(const u32x4*)(xb + (size_t)(rowb + k * 16) * 1024 + col0 + bj * HALF);
#pragma unroll
            for (int k = 0; k < 8; ++k) {
                    const int ai = k >> 2, m = k & 3;
                    const int row = rowb + ai * HALF + m * 16; const size_t off = (size_t)row * 1024 + col0; float sq = 0.f;
                    const u32x4 w0 = xw[k][0], w1 = xw[k][1];
                    if (k < 4) {
#pragma unroll
                        for (int bj = 0; bj < 2; ++bj) xw[k + 4][bj] = *(const u32x4*)(xb + (size_t)(rowb + HALF + k * 16) * 1024 + col0 + bj * HALF);
                    }
#pragma unroll
                    for (int bj = 0; bj < 2; ++bj) {
                        const u32x4 w = bj ? w1 : w0;
                        const f32x4 x0 = (f32x4){__uint_as_float(w.x << 16), __uint_as_float(w.x & 0xffff0000u), __uint_as_float(w.y << 16), __uint_as_float(w.y & 0xffff0000u)};
                        const f32x4 x1 = (f32x4){__uint_as_float(w.z << 16), __uint_as_float(w.z & 0xffff0000u), __uint_as_float(w.w << 16), __uint_as_float(w.w & 0xffff0000u)};
                        const f32x4 v0 = x0 + acc[ai][bj][m][0], v1 = x1 + acc[ai][bj][m][1];
                        if (xout) { *(f32x4*)(xout + off + bj * HALF) = v0; *(f32x4*)(xout + off + bj * HALF + 4) = v1; }
                        sq += (v0[0] * v0[0] + v0[1] * v0[1]) + (v0[2] * v0[2] + v0[3] * v0[3]) + (v1[0] * v1[0] + v1[1] * v1[1]) + (v1[2] * v1[2] + v1[3] * v1[3]);
                        if (o0) *(u32x4*)(o0 + off + bj * HALF) = pack8(v0, v1);
                    }
                    sq = quad_sum(sq);
                    if (fq == 0) ssq[(size_t)row * 16 + pn * 4 + wc] = sq;
                }
        } else if (mode == 4) {
            const int col0 = pn * HALF + wc * 32 + 8 * fq;
#pragma unroll
            for (int ai = 0; ai < 2; ++ai)
#pragma unroll
                for (int m = 0; m < 4; ++m) {
                    const int row = rowb + ai * HALF + m * 16; const float rs = rsv[ai][m]; f32x4 h[2];
                    const float rsc = rs * -1.4426950408889634f, rs2 = rs * rs;
                    const f32x4 a0 = acc[ai][0][m][0], a1 = acc[ai][0][m][1], b0 = acc[ai][1][m][0], b1 = acc[ai][1][m][1];
                    const f32x4 t0 = a0 * rsc, t1 = a1 * rsc; f32x4 e0, e1;
#pragma unroll
                    for (int e = 0; e < 4; ++e) { e0[e] = __builtin_amdgcn_exp2f(t0[e]); e1[e] = __builtin_amdgcn_exp2f(t1[e]); }
                    const f32x4 d0 = e0 + 1.0f, d1 = e1 + 1.0f, p0 = (a0 * b0) * rs2, p1 = (a1 * b1) * rs2; f32x4 r0, r1;
#pragma unroll
                    for (int e = 0; e < 4; ++e) { r0[e] = __builtin_amdgcn_rcpf(d0[e]); r1[e] = __builtin_amdgcn_rcpf(d1[e]); }
                    h[0] = p0 * r0; h[1] = p1 * r1;
                    *(u32x4*)(o0 + (size_t)row * 2816 + col0) = pack8(h[0], h[1]);
                }
        } else if (mode == 0) {
            if (pn < 8) {
                bf16_t* dst = (pn < 4) ? o0 : o1; const float sc = (pn < 4) ? QK_C2 : 1.0f; const int head = (pn & 3) * 4 + wc;
                int posv[2][4];
#pragma unroll
                for (int ai = 0; ai < 2; ++ai)
#pragma unroll
                    for (int m = 0; m < 4; ++m) posv[ai][m] = pos[rowb + ai * HALF + m * 16];
                f32x4 iva, ivb;
#pragma unroll
                for (int e = 0; e < 4; ++e) { iva[e] = __builtin_amdgcn_exp2f(-(float)(8 * fq + e) * 0.41524101186092029f) * 0.15915494309189535f; ivb[e] = __builtin_amdgcn_exp2f(-(float)(8 * fq + 4 + e) * 0.41524101186092029f) * 0.15915494309189535f; }
#pragma unroll
                for (int ai = 0; ai < 2; ++ai)
#pragma unroll
                    for (int m = 0; m < 4; ++m) {
                        const int row = rowb + ai * HALF + m * 16; const float rs = rsv[ai][m] * sc; const float pf = (float)posv[ai][m];
                        f32x4 ca, cb, sa, sb;
#pragma unroll
                        for (int e = 0; e < 4; ++e) { const float ra = __builtin_amdgcn_fractf(pf * iva[e]), rb = __builtin_amdgcn_fractf(pf * ivb[e]);
                            ca[e] = __builtin_amdgcn_cosf(ra); sa[e] = __builtin_amdgcn_sinf(ra); cb[e] = __builtin_amdgcn_cosf(rb); sb[e] = __builtin_amdgcn_sinf(rb); }
                        const f32x4 x1a = acc[ai][0][m][0] * rs, x1b = acc[ai][0][m][1] * rs, x2a = acc[ai][1][m][0] * rs, x2b = acc[ai][1][m][1] * rs;
                        const f32x4 o1a = x1a * ca - x2a * sa, o1b = x1b * cb - x2b * sb, o2a = x2a * ca + x1a * sa, o2b = x2b * cb + x1b * sb;
                        bf16_t* p = dst + (size_t)row * 1024 + head * 64 + 8 * fq;
                        *(u32x4*)p = pack8(o1a, o1b); *(u32x4*)(p + 32) = pack8(o2a, o2b);
                    }
            } else {
                const int col0 = (pn - 8) * BM + wc * 32 + 8 * fq;
#pragma unroll
                for (int ai = 0; ai < 2; ++ai)
#pragma unroll
                    for (int m = 0; m < 4; ++m) {
                        const int row = rowb + ai * HALF + m * 16; const float rs = rsv[ai][m];
#pragma unroll
                        for (int bj = 0; bj < 2; ++bj) *(u32x4*)(o2 + (size_t)row * 1024 + col0 + bj * HALF) = pack8(acc[ai][bj][m][0] * rs, acc[ai][bj][m][1] * rs);
                    }
            }
        } else if (mode == 1) {
            const int col0 = pn * BM + wc * 32 + 8 * fq; const bool isv = pn >= 6;
            bf16_t* dst = isv ? (o1 + col0 - 1536) : (o0 + col0);
            f32x4 bv[2][2];
#pragma unroll
            for (int bj = 0; bj < 2; ++bj)
#pragma unroll
                for (int n = 0; n < 2; ++n) bv[bj][n] = *(const f32x4*)(bias + col0 + bj * HALF + 4 * n);
#pragma unroll
            for (int ai = 0; ai < 2; ++ai)
#pragma unroll
                for (int m = 0; m < 4; ++m) {
                    const int row = rowb + ai * HALF + m * 16; const float rs = rsv[ai][m]; float s1 = 0.f, s2 = 0.f;
#pragma unroll
                    for (int bj = 0; bj < 2; ++bj) {
                        f32x4 v0 = acc[ai][bj][m][0] * rs + bv[bj][0], v1 = acc[ai][bj][m][1] * rs + bv[bj][1];
                        gelu8(v0, v1);
                        s1 += ((v0[0] + v0[1]) + (v0[2] + v0[3])) + ((v1[0] + v1[1]) + (v1[2] + v1[3]));
                        s2 += (v0[0] * v0[0] + v0[1] * v0[1]) + (v0[2] * v0[2] + v0[3] * v0[3]) + (v1[0] * v1[0] + v1[1] * v1[1]) + (v1[2] * v1[2] + v1[3] * v1[3]);
                        *(u32x4*)(dst + (size_t)row * 1536 + bj * HALF) = pack8(v0, v1);
                    }
                    if (isv) { s1 = quad_sum(s1); s2 = quad_sum(s2); if (fq == 0) vstat[(size_t)row * 24 + (pn - 6) * 4 + wc] = (f32x2e){s1, s2}; }
                }
        } else {
#pragma unroll
            for (int ai = 0; ai < 2; ++ai)
#pragma unroll
                for (int m = 0; m < 4; ++m) {
                    const int row = rowb + ai * HALF + m * 16; const float rs = rsv[ai][m];
                    if (pn < 4) {
#pragma unroll
                        for (int bj = 0; bj < 2; ++bj) *(u32x4*)(o0 + (size_t)row * 1024 + pn * BM + wc * 32 + 8 * fq + bj * HALF) = pack8(acc[ai][bj][m][0] * rs, acc[ai][bj][m][1] * rs);
                    } else {
                        const float r2 = rs * rs;
                        *(u32x4*)(o1 + (size_t)row * 1024 + (pn - 4) * HALF + wc * 32 + 8 * fq) = pack8(acc[ai][0][m][0] * acc[ai][1][m][0] * r2, acc[ai][0][m][1] * acc[ai][1][m][1] * r2);
                    }
                }
        }
    }
};

template <class Epi, class Sched, bool ALIGN_EPI = false, bool SP2 = false>
__device__ __forceinline__ void gemm_phase(PG8_LAS unsigned char* lds, const Gemm g, const Sched& S, const Epi& E, const int tid) {
    const int wid = __builtin_amdgcn_readfirstlane(tid >> 6), lane = tid & 63, wr = wid >> 2, wc = wid & 3, fr = lane & 15, fq = lane >> 4;
    const int K = g.K, nt = K / BK;
    unsigned voffA[2], voffB[2];
#pragma unroll
    for (int i = 0; i < 2; ++i) { int R, C; stage_rc(tid * 16 + i * 8192, R, C); const int Rb = Epi::PERM ? ((R & ~31) + perm32(R & 31)) : R;
        voffA[i] = (unsigned)(R * K + C) * 2u; voffB[i] = (unsigned)(Rb * K + C) * 2u; }
    const size_t kstep = (size_t)(BK * 2);
    const size_t hstep = (size_t)HALF * K * 2;
    const size_t tstep = 2 * hstep;
    const unsigned ldsw = (unsigned)wid * 1024u;
    const int aoff = lds_byte(wr * 64 + fr, fq * 8), boff = lds_byte(wc * 32 + fr, fq * 8);
#define PG8_SA(b, h) (((b) * 2 + (h)) * HTB)
#define PG8_SB(b, h) ((4 + (b) * 2 + (h)) * HTB)
#define PG8_STAGE(bufoff, gbase, voff) do { _Pragma("unroll") for (int _i = 0; _i < 2; ++_i) \
        __builtin_amdgcn_global_load_lds((const unsigned*)((const char*)(gbase) + (voff)[_i]), (PG8_LAS unsigned*)(lds + (bufoff) + ldsw + _i * 8192), 16, 0, 0); } while (0)
#define PG8_LDA(dst, b, h) do { _Pragma("unroll") for (int m = 0; m < 4; ++m) _Pragma("unroll") for (int k = 0; k < 2; ++k) dst[m][k] = *(const PG8_LAS bf16x8*)(lds + PG8_SA(b, h) + aoff + m * 2048 + k * 1024); } while (0)
#define PG8_LDB(dst, b, h) do { _Pragma("unroll") for (int n = 0; n < 2; ++n) _Pragma("unroll") for (int k = 0; k < 2; ++k) dst[n][k] = *(const PG8_LAS bf16x8*)(lds + PG8_SB(b, h) + boff + n * 2048 + k * 1024); } while (0)
#define PG8_MMA(ai, bj, At, Bt) do { __builtin_amdgcn_s_setprio(1); _Pragma("unroll") for (int m = 0; m < 4; ++m) _Pragma("unroll") for (int n = 0; n < 2; ++n) _Pragma("unroll") for (int k = 0; k < 2; ++k) \
        acc[ai][bj][m][n] = __builtin_amdgcn_mfma_f32_16x16x32_bf16(Bt[n][k], At[m][k], acc[ai][bj][m][n], 0, 0, 0); __builtin_amdgcn_s_setprio(0); } while (0)
#define PG8_WAIT_V(n) asm volatile("s_waitcnt vmcnt(" #n ")" ::: "memory")
#define PG8_WAIT_L(n) asm volatile("s_waitcnt lgkmcnt(" #n ")" ::: "memory")
#define PG8_BAR __builtin_amdgcn_s_barrier()
#define PG8_SCHED __builtin_amdgcn_sched_barrier(0)
    Unit cur, nxt; int ui = 0;
    if (!S.next(0, cur)) return;
    f32x4 acc[2][2][4][2];
#pragma unroll
    for (int a = 0; a < 2; ++a)
#pragma unroll
        for (int b = 0; b < 2; ++b)
#pragma unroll
            for (int m = 0; m < 4; ++m)
#pragma unroll
                for (int n = 0; n < 2; ++n) acc[a][b][m][n] = (f32x4){0.f, 0.f, 0.f, 0.f};
    bf16x8 At[4][2], B0[2][2], B1[2][2];
    const char* cA = (const char*)g.A + (size_t)cur.pm * tstep; const char* cB = (const char*)g.Bt + (size_t)cur.pn * tstep;
    S.a_ready(cur);
    if constexpr (SP2) {
        PG8_STAGE(PG8_SB(0, 0), cB, voffB); PG8_STAGE(PG8_SB(0, 1), cB + hstep, voffB); PG8_STAGE(PG8_SA(0, 0), cA, voffA); PG8_STAGE(PG8_SA(0, 1), cA + hstep, voffA);
        if (wr == 1) PG8_BAR;
        PG8_WAIT_V(2); PG8_BAR;
        PG8_STAGE(PG8_SB(1, 0), cB + kstep, voffB); PG8_STAGE(PG8_SA(1, 0), cA + kstep, voffA); PG8_STAGE(PG8_SB(1, 1), cB + hstep + kstep, voffB);
        PG8_WAIT_V(6); PG8_BAR;
    } else {
        PG8_STAGE(PG8_SB(0, 0), cB, voffB); PG8_STAGE(PG8_SA(0, 0), cA, voffA); PG8_STAGE(PG8_SB(0, 1), cB + hstep, voffB); PG8_STAGE(PG8_SA(0, 1), cA + hstep, voffA);
        if (wr == 1) PG8_BAR;
        PG8_WAIT_V(4); PG8_BAR;
        PG8_STAGE(PG8_SB(1, 0), cB + kstep, voffB); PG8_STAGE(PG8_SA(1, 0), cA + kstep, voffA); PG8_STAGE(PG8_SB(1, 1), cB + hstep + kstep, voffB);
        PG8_WAIT_V(6); PG8_BAR;
    }
    for (;;) {
        const bool has_next = S.next(ui + 1, nxt);
        const char* nA = has_next ? (const char*)g.A + (size_t)nxt.pm * tstep : cA; const char* nB = has_next ? (const char*)g.Bt + (size_t)nxt.pn * tstep : cB;
        for (int t = 0; t < nt; t += 2) {
            const bool last = (t == nt - 2);
            const char* a1 = cA + (size_t)(t + 1) * kstep;
            const char* a2 = last ? nA : cA + (size_t)(t + 2) * kstep; const char* b2 = last ? nB : cB + (size_t)(t + 2) * kstep;
            const char* a3 = a2 + kstep; const char* b3 = b2 + kstep;
            if (last && has_next) S.a_ready(nxt);
            if constexpr (SP2) {
            PG8_LDB(B0, 0, 0); PG8_LDB(B1, 0, 1); PG8_SCHED; PG8_LDA(At, 0, 0); PG8_STAGE(PG8_SA(1, 1), a1 + hstep, voffA);
            PG8_WAIT_V(8); PG8_WAIT_L(0); PG8_BAR; PG8_MMA(0, 0, At, B0); PG8_MMA(0, 1, At, B1); PG8_BAR; PG8_SCHED;
            PG8_LDA(At, 0, 1); PG8_STAGE(PG8_SB(0, 0), b2, voffB); PG8_STAGE(PG8_SB(0, 1), b2 + hstep, voffB); PG8_STAGE(PG8_SA(0, 0), a2, voffA);
            PG8_WAIT_V(8); PG8_WAIT_L(0); PG8_BAR; PG8_MMA(1, 0, At, B0); PG8_MMA(1, 1, At, B1); PG8_BAR; PG8_SCHED;
            PG8_LDB(B0, 1, 0); PG8_LDB(B1, 1, 1); PG8_SCHED; PG8_LDA(At, 1, 0); PG8_STAGE(PG8_SA(0, 1), a2 + hstep, voffA);
            PG8_WAIT_V(8); PG8_WAIT_L(0); PG8_BAR; PG8_MMA(0, 0, At, B0); PG8_MMA(0, 1, At, B1); PG8_BAR; PG8_SCHED;
            PG8_LDA(At, 1, 1); PG8_STAGE(PG8_SB(1, 0), b3, voffB); PG8_STAGE(PG8_SB(1, 1), b3 + hstep, voffB); PG8_STAGE(PG8_SA(1, 0), a3, voffA);
            PG8_WAIT_V(8); PG8_WAIT_L(0); PG8_BAR; PG8_MMA(1, 0, At, B0); PG8_MMA(1, 1, At, B1); PG8_BAR; PG8_SCHED;
            } else {
            PG8_LDB(B0, 0, 0); PG8_SCHED; PG8_LDA(At, 0, 0); PG8_STAGE(PG8_SA(1, 1), a1 + hstep, voffA);
            PG8_WAIT_L(8); PG8_BAR; PG8_WAIT_L(0); PG8_MMA(0, 0, At, B0); PG8_BAR; PG8_SCHED;
            PG8_LDB(B1, 0, 1); PG8_STAGE(PG8_SB(0, 0), b2, voffB);
            PG8_BAR; PG8_WAIT_L(0); PG8_MMA(0, 1, At, B1); PG8_BAR;
            PG8_LDA(At, 0, 1); PG8_STAGE(PG8_SA(0, 0), a2, voffA);
            PG8_BAR; PG8_WAIT_L(0); PG8_MMA(1, 0, At, B0); PG8_BAR; PG8_SCHED;
            PG8_STAGE(PG8_SB(0, 1), b2 + hstep, voffB);
            PG8_WAIT_V(6); PG8_BAR; PG8_MMA(1, 1, At, B1); PG8_BAR;
            PG8_LDB(B0, 1, 0); PG8_SCHED; PG8_LDA(At, 1, 0); PG8_STAGE(PG8_SA(0, 1), a2 + hstep, voffA);
            PG8_WAIT_L(8); PG8_BAR; PG8_WAIT_L(0); PG8_MMA(0, 0, At, B0); PG8_BAR; PG8_SCHED;
            PG8_LDB(B1, 1, 1); PG8_STAGE(PG8_SB(1, 0), b3, voffB);
            PG8_BAR; PG8_WAIT_L(0); PG8_MMA(0, 1, At, B1); PG8_BAR;
            PG8_LDA(At, 1, 1); PG8_STAGE(PG8_SA(1, 0), a3, voffA);
            PG8_BAR; PG8_WAIT_L(0); PG8_MMA(1, 0, At, B0); PG8_BAR; PG8_SCHED;
            PG8_STAGE(PG8_SB(1, 1), b3 + hstep, voffB);
            PG8_WAIT_V(6); PG8_BAR; PG8_MMA(1, 1, At, B1); PG8_BAR;
            }
        }
        if constexpr (ALIGN_EPI) { if (wr == 0) PG8_BAR; }
        if constexpr (!Epi::AFTER_DRAIN) { E(acc, cur, wr, wc, fr, fq); S.done(cur); }
        if (!has_next) break;
#pragma unroll
        for (int a = 0; a < 2; ++a)
#pragma unroll
            for (int b = 0; b < 2; ++b)
#pragma unroll
                for (int m = 0; m < 4; ++m)
#pragma unroll
                    for (int n = 0; n < 2; ++n) acc[a][b][m][n] = (f32x4){0.f, 0.f, 0.f, 0.f};
        cur = nxt; cA = nA; cB = nB; ++ui;
        if constexpr (ALIGN_EPI) { if (wr == 1) PG8_BAR; }
    }
    PG8_WAIT_V(0);
    if constexpr (!ALIGN_EPI) { if (wr == 0) PG8_BAR; }
    PG8_BAR;
    if constexpr (Epi::AFTER_DRAIN) { E.fused(acc, cur, wr, wc, fr, fq, lds, wid, lane); S.done(cur); }
#undef PG8_SA
#undef PG8_SB
#undef PG8_STAGE
#undef PG8_LDA
#undef PG8_LDB
#undef PG8_MMA
#undef PG8_WAIT_V
#undef PG8_WAIT_L
#undef PG8_BAR
#undef PG8_SCHED
}
}
#include <hip/hip_bf16.h>
#include <cmath>
namespace attn_body {
using bf16=__hip_bfloat16;
using bf16x8=__attribute__((ext_vector_type(8)))short;
using s16x4=__attribute__((ext_vector_type(4)))short;
using f32x16=__attribute__((ext_vector_type(16)))float;
using u32x4=__attribute__((ext_vector_type(4)))unsigned;
constexpr int BATCH=32,NHEAD=16,SEQ=2048,D=64,DM=NHEAD*D,OPITCH=2048;
constexpr int NW=8,QBLK=32,QB=QBLK*NW,KVBLK=64,NQB=SEQ/QB;
constexpr int ATTN_PITCH=DM, ATTN_UNIT_ROWS=QB;
__device__ __forceinline__ int crow(int r,int hi){return (r&3)+8*(r>>2)+4*hi;}
#define SBAR() __builtin_amdgcn_sched_barrier(0)
__device__ __forceinline__ void cmask(f32x16&p0,f32x16&p1,int jb,int qrel,int hi){
  const float NEG=-INFINITY; int kb=64*jb+4*hi;
  #pragma unroll
  for(int r=0;r<16;++r){int kv=kb+(r&3)+8*(r>>2); if(kv>qrel)p0[r]=NEG; if(kv+32>qrel)p1[r]=NEG;}
}

constexpr int NSLOT=3, SLOTB=8192;
constexpr int LDS_K=0, LDS_V=NSLOT*SLOTB, LDS_WS=LDS_V+NSLOT*2*SLOTB, LDS_OST=LDS_WS+NW*64*4, LDS_BYTES=LDS_OST+NW*8192;
constexpr float C2=0.125f*1.4426950408889634f;
__device__ __forceinline__ void glds16(const void*gsrc,unsigned lds_dst){unsigned keep;
  asm volatile("s_mov_b32 %0, m0\n\ts_mov_b32 m0, %2\n\ts_nop 0\n\tglobal_load_lds_dwordx4 %1, off\n\ts_mov_b32 m0, %0":"=&s"(keep):"v"(gsrc),"s"(lds_dst):"memory");}
__device__ __forceinline__ float max3f(float a,float b,float c){float r;asm("v_max3_f32 %0, %1, %2, %3":"=v"(r):"v"(a),"v"(b),"v"(c));return r;}
__device__ __forceinline__ float max2f(float a,float b){float r;asm("v_max_f32_e32 %0, %1, %2":"=v"(r):"v"(a),"v"(b));return r;}
__device__ __forceinline__ float fadd_s(float a,float b){float r;asm("v_add_f32_e32 %0, %1, %2":"=v"(r):"v"(a),"v"(b));return r;}
__device__ __forceinline__ float fsub_s(float a,float b){float r;asm("v_sub_f32_e32 %0, %1, %2":"=v"(r):"v"(a),"v"(b));return r;}
typedef float f32x2_t __attribute__((ext_vector_type(2))); typedef __bf16 bf16x2_t __attribute__((ext_vector_type(2)));
__device__ __forceinline__ unsigned cvtpk_s(float lo,float hi){f32x2_t v={lo,hi};bf16x2_t b=__builtin_convertvector(v,bf16x2_t);return __builtin_bit_cast(unsigned,b);}
#define WAIT_BAR(N) asm volatile("s_waitcnt vmcnt(" #N ") lgkmcnt(0)\n\ts_barrier":::"memory")

__device__ __forceinline__ void qkt(f32x16&p0,f32x16&p1,const char*Kslot,const bf16x8*qr,const f32x16&negm,int r32,int hi){
  const char*kb=Kslot+hi*1024+r32*16;
  #pragma unroll
  for(int d0=0;d0<4;++d0){
    const bf16x8 b0=*reinterpret_cast<const bf16x8*>(kb+d0*2048);
    const bf16x8 b1=*reinterpret_cast<const bf16x8*>(kb+d0*2048+512);
    if(d0==0){p0=__builtin_amdgcn_mfma_f32_32x32x16_bf16(b0,qr[0],negm,0,0,0);p1=__builtin_amdgcn_mfma_f32_32x32x16_bf16(b1,qr[0],negm,0,0,0);}
    else{p0=__builtin_amdgcn_mfma_f32_32x32x16_bf16(b0,qr[d0],p0,0,0,0);p1=__builtin_amdgcn_mfma_f32_32x32x16_bf16(b1,qr[d0],p1,0,0,0);}}
}
typedef __attribute__((address_space(3))) const char* lds_cptr;
typedef short v4i16_t __attribute__((ext_vector_type(4)));
__device__ __forceinline__ void kload8(bf16x8*kf,lds_cptr kp){
  kf[0]=*(const __attribute__((address_space(3))) bf16x8*)(kp);      kf[1]=*(const __attribute__((address_space(3))) bf16x8*)(kp+512);
  kf[2]=*(const __attribute__((address_space(3))) bf16x8*)(kp+2048); kf[3]=*(const __attribute__((address_space(3))) bf16x8*)(kp+2560);
  kf[4]=*(const __attribute__((address_space(3))) bf16x8*)(kp+4096); kf[5]=*(const __attribute__((address_space(3))) bf16x8*)(kp+4608);
  kf[6]=*(const __attribute__((address_space(3))) bf16x8*)(kp+6144); kf[7]=*(const __attribute__((address_space(3))) bf16x8*)(kp+6656);
}
__device__ __forceinline__ void kload2(bf16x8*kf,lds_cptr kp,int j){ kf[2*j]=*(const __attribute__((address_space(3))) bf16x8*)(kp+j*2048); kf[2*j+1]=*(const __attribute__((address_space(3))) bf16x8*)(kp+j*2048+512); }
__device__ __forceinline__ s16x4 vtr(lds_cptr p){ return __builtin_bit_cast(s16x4,__builtin_amdgcn_ds_read_tr16_b64_v4i16((__attribute__((address_space(3))) v4i16_t*)p)); }
__device__ __forceinline__ float rowmax(const f32x16&p0,const f32x16&p1){
  float a=max3f(p0[0],p0[1],p1[0]),b=max3f(p0[2],p0[3],p1[1]);a=max3f(a,p1[2],p1[3]);
  #pragma unroll
  for(int r=4;r<16;r+=4){a=max3f(a,p0[r],p0[r+1]);b=max3f(b,p0[r+2],p0[r+3]);a=max3f(a,p1[r],p1[r+1]);b=max3f(b,p1[r+2],p1[r+3]);}
  const float m=max2f(a,b);
  auto rr=__builtin_amdgcn_permlane32_swap(__float_as_uint(m),__float_as_uint(m),false,false);
  return max2f(__uint_as_float(rr[0]),__uint_as_float(rr[1]));
}
__device__ __forceinline__ void pv(f32x16*o,int vb,bf16x8 pa0,bf16x8 pa1,bf16x8 pa2,bf16x8 pa3){
  #pragma unroll
  for(int d0=0;d0<4;++d0){s16x4 lo[4],hi[4];
    #pragma unroll
    for(int ks=0;ks<4;++ks){
      asm volatile("ds_read_b64_tr_b16 %0,%1 offset:%c2":"=&v"(lo[ks]):"v"(vb),"i"(d0*4096+ks*1024):"memory");
      asm volatile("ds_read_b64_tr_b16 %0,%1 offset:%c2":"=&v"(hi[ks]):"v"(vb),"i"(d0*4096+ks*1024+512):"memory");}
    asm volatile("s_waitcnt lgkmcnt(0)":::"memory");SBAR();
    #define PK(k) (bf16x8){lo[k][0],lo[k][1],lo[k][2],lo[k][3],hi[k][0],hi[k][1],hi[k][2],hi[k][3]}
    o[d0]=__builtin_amdgcn_mfma_f32_32x32x16_bf16(pa0,PK(0),o[d0],0,0,0);
    o[d0]=__builtin_amdgcn_mfma_f32_32x32x16_bf16(pa1,PK(1),o[d0],0,0,0);
    o[d0]=__builtin_amdgcn_mfma_f32_32x32x16_bf16(pa2,PK(2),o[d0],0,0,0);
    o[d0]=__builtin_amdgcn_mfma_f32_32x32x16_bf16(pa3,PK(3),o[d0],0,0,0);
    #undef PK
  }
}

#ifndef ATTN_STORE16
#define ATTN_STORE16(p,v) (*(u32x4*)(p)=(v))
#endif
template<int THRL> __device__ __forceinline__ void attn_unit(int b,int h,int vcol,int ocol,int qb,const bf16*Q,const bf16*__restrict__ K,const bf16*__restrict__ V,bf16*O,char*shm,const int tid_in,const bool fuse,const unsigned lamf_bits,const unsigned oscale_bits,const float*subln,bf16*OC,const int occol){
  int tid=tid_in; asm volatile("":"+v"(tid)); tid&=511;
  const int lane=tid&63,r32=lane&31,hi=lane>>5; const int wid=__builtin_amdgcn_readfirstlane(tid>>6);
  const long rowbase=(long)b*SEQ; const int q0=qb*QB;
  const bf16*Qw=Q+(rowbase+q0+wid*QBLK)*DM+h*D;
  const bf16*Kh=K+rowbase*DM+h*D,*Vh=V+rowbase*DM+vcol;
  const unsigned lds0=(unsigned)(uintptr_t)shm;
  float*wsf=(float*)(shm+LDS_WS)+wid*64;
  const bf16*ksrc=Kh+(long)lane*DM+wid*8;
  const bf16*vsrc=Vh+(long)(16*(wid&3)+(lane>>2))*DM+(wid>>2)*32+(lane&3)*8;
  const unsigned kdst=lds0+LDS_K+wid*1024, vdst=lds0+LDS_V+wid*1024;
  #define DMA_K(t,slot) glds16(ksrc+(long)(t)*KVBLK*DM,(unsigned)__builtin_amdgcn_readfirstlane(kdst+(slot)))
  #define DMA_V(t,slot) do{ glds16(vsrc+(long)(t)*KVBLK*DM,(unsigned)__builtin_amdgcn_readfirstlane(vdst+2*(slot))); glds16(vsrc+(long)(t)*KVBLK*DM+64,(unsigned)__builtin_amdgcn_readfirstlane(vdst+2*(slot)+8192)); }while(0)
  const int vb0=(int)(lds0+LDS_V)+((lane>>4)&1)*32+(lane&3)*8+(4*hi+((lane&15)>>2))*64;
  const char*Kbase=shm+LDS_K; bf16x8 kf[8];
  const lds_cptr shm3=(lds_cptr)shm; const lds_cptr kp0=shm3+LDS_K+hi*1024+r32*16; const lds_cptr vp0=shm3+LDS_V+((lane>>4)&1)*32+(lane&3)*8+(4*hi+((lane&15)>>2))*64;
  const int NT=(q0+QB)/KVBLK;
  DMA_K(0,0);DMA_V(0,0);DMA_K(1,SLOTB);
  bf16x8 qr[4];
  #pragma unroll
  for(int d0=0;d0<4;++d0)qr[d0]=*reinterpret_cast<const bf16x8*>(&Qw[(long)r32*DM+d0*16+hi*8]);
  float mhat=0.f,l_reg=0.f;f32x16 o[4];f32x16 negm; { float zz; asm volatile("v_mov_b32 %0, 0":"=v"(zz));
    _Pragma("unroll") for(int r=0;r<16;++r){o[0][r]=zz;o[1][r]=zz;o[2][r]=zz;o[3][r]=zz;negm[r]=zz;} } asm volatile("":"+v"(negm));
  const int qrel=wid*QBLK+r32;
  #define CMASK(P0,P1,t) do{int jb_=(t)-(NT-4); if(jb_>=0)cmask(P0,P1,jb_,qrel,hi);}while(0)
  bool resc=false;
  #define START(P0,P1) do{ const float rm=rowmax(P0,P1); resc=false; \
    { const float dl=rm; mhat=fadd_s(mhat,dl); \
      _Pragma("unroll") for(int r=0;r<16;++r){P0[r]=fsub_s(P0[r],dl);P1[r]=fsub_s(P1[r],dl);} \
      _Pragma("unroll") for(int r=0;r<16;++r)negm[r]=-mhat; asm volatile("":"+v"(negm)); } \
    _Pragma("unroll") for(int r=0;r<16;++r)P0[r]=__builtin_amdgcn_exp2f(P0[r]); }while(0)
  #define RESC() do{ if(resc){ asm volatile("s_waitcnt lgkmcnt(0)":::"memory"); \
      _Pragma("unroll") for(int d_=0;d_<4;++d_) _Pragma("unroll") for(int r=0;r<16;++r)o[d_][r]*=wsf[crow(r,hi)]; } }while(0)
  f32x16 pA0,pA1,pB0,pB1;
  int sl_prev=0,sl_cur=0,sl_next=SLOTB;
  #define ROT() do{sl_prev=sl_cur;sl_cur=sl_next;sl_next=(sl_next==(NSLOT-1)*SLOTB)?0:sl_next+SLOTB;}while(0)
  DMA_K(2,2*SLOTB);
  WAIT_BAR(3);
  qkt(pA0,pA1,Kbase,qr,negm,r32,hi);asm volatile("s_nop 15\n\ts_nop 7":"+v"(pA0),"+v"(pA1));CMASK(pA0,pA1,0);
  START(pA0,pA1);
  _Pragma("unroll") for(int r=0;r<16;++r)pA1[r]=__builtin_amdgcn_exp2f(pA1[r]);
  WAIT_BAR(0);
  DMA_K(3,0);DMA_V(1,SLOTB);
  ROT();
  kload8(kf,kp0+sl_cur);
  WAIT_BAR(3);
  s16x4 vlo[8],vhi[8]; u32x4 pw0,pw1,pw2,pw3;
  #define PKW(P,B) cvtpk_s(P[B],P[B+1])
  #define PAF(k) __builtin_bit_cast(bf16x8,pw##k)
  #define VFR(i) (bf16x8){vlo[i][0],vlo[i][1],vlo[i][2],vlo[i][3],vhi[i][0],vhi[i][1],vhi[i][2],vhi[i][3]}
  #define PIN(x) asm volatile("":"+v"(x))
  #define MX3(a,b,c) __builtin_fmaxf(__builtin_fmaxf((a),(b)),(c))
  #define GAPA(MF,A0,A1,A2,A3,W0,W1,PW) do{ MF; sacc+=A0; sacc+=A1; sacc+=A2; sacc+=A3; PIN(sacc); W0; W1; PIN(PW); SBAR(); }while(0)
  #define EX(v) __builtin_amdgcn_exp2f(v)
  #define GAPB(MF,R,X,B) do{ MF; R; X[B]=EX(X[B]); X[B+1]=EX(X[B+1]); PIN(X); SBAR(); }while(0)
  #define VRD2(i) do{ vlo[i]=vtr(vp_+((((i)>>2)+2)*4096+((i)&3)*1024)); vhi[i]=vtr(vp_+((((i)>>2)+2)*4096+((i)&3)*1024+512)); }while(0)
  #define VRD(i) do{ vlo[i]=vtr(vp_+(((i)>>2)*4096+((i)&3)*1024)); vhi[i]=vtr(vp_+(((i)>>2)*4096+((i)&3)*1024+512)); }while(0)
  #define KRD(G,j) do{ if(G){ kload2(kf,kp0+sl_next,j); SBAR(); } }while(0)
  #define STEP(C0,C1,P0,P1,t,GK,GV,GL) do{ SBAR(); \
    const lds_cptr vp_=vp0+2*sl_prev; \
    VRD(0); SBAR(); float sacc=(P0[0]+P0[1]); \
    GAPA(C0=__builtin_amdgcn_mfma_f32_32x32x16_bf16(kf[0],qr[0],negm,0,0,0), P0[2],P0[3],P0[4],P0[5],     pw0[0]=PKW(P0,0), pw0[1]=PKW(P0,2), pw0); \
    VRD(4); SBAR(); GAPA(C1=__builtin_amdgcn_mfma_f32_32x32x16_bf16(kf[1],qr[0],negm,0,0,0), P0[6],P0[7],P0[8],P0[9],     pw0[2]=PKW(P0,4), pw0[3]=PKW(P0,6), pw0); \
    VRD(1); SBAR(); GAPA(C0=__builtin_amdgcn_mfma_f32_32x32x16_bf16(kf[2],qr[1],C0,0,0,0),   P0[10],P0[11],P0[12],P0[13], pw1[0]=PKW(P0,8), pw1[1]=PKW(P0,10), pw1); \
    VRD(5); SBAR(); GAPA(C1=__builtin_amdgcn_mfma_f32_32x32x16_bf16(kf[3],qr[1],C1,0,0,0),   P0[14],P0[15],P1[0],P1[1],   pw1[2]=PKW(P0,12),pw1[3]=PKW(P0,14), pw1); \
    VRD(2); SBAR(); GAPA(C0=__builtin_amdgcn_mfma_f32_32x32x16_bf16(kf[4],qr[2],C0,0,0,0),   P1[2],P1[3],P1[4],P1[5],     pw2[0]=PKW(P1,0), pw2[1]=PKW(P1,2), pw2); \
    VRD(6); SBAR(); GAPA(C1=__builtin_amdgcn_mfma_f32_32x32x16_bf16(kf[5],qr[2],C1,0,0,0),   P1[6],P1[7],P1[8],P1[9],     pw2[2]=PKW(P1,4), pw2[3]=PKW(P1,6), pw2); \
    VRD(3); SBAR(); GAPA(C0=__builtin_amdgcn_mfma_f32_32x32x16_bf16(kf[6],qr[3],C0,0,0,0),   P1[10],P1[11],P1[12],P1[13], pw3[0]=PKW(P1,8), pw3[1]=PKW(P1,10), pw3); \
    VRD(7); SBAR(); GAPA(C1=__builtin_amdgcn_mfma_f32_32x32x16_bf16(kf[7],qr[3],C1,0,0,0),   P1[14],P1[15],0.f,0.f,       pw3[2]=PKW(P1,12),pw3[3]=PKW(P1,14), pw3); \
    l_reg+=sacc; \
    if(GK){DMA_K((t)+3,sl_cur);} if(GV){DMA_V((t)+1,sl_next);} \
    CMASK(C0,C1,t); \
    { float a=MX3(C0[0],C0[1],C1[0]),b=MX3(C0[2],C0[3],C1[1]); a=MX3(a,C1[2],C1[3]); \
      _Pragma("unroll") for(int r=4;r<16;r+=4){a=MX3(a,C0[r],C0[r+1]);b=MX3(b,C0[r+2],C0[r+3]);a=MX3(a,C1[r],C1[r+1]);b=MX3(b,C1[r+2],C1[r+3]);} \
      float rm=__builtin_fmaxf(a,b); { auto rr=__builtin_amdgcn_permlane32_swap(__float_as_uint(rm),__float_as_uint(rm),false,false); rm=__builtin_fmaxf(__uint_as_float(rr[0]),__uint_as_float(rr[1])); } \
      resc=false; \
      if(__builtin_expect(__any(rm>(float)THRL),0)){ const float dl=__builtin_fmaxf(rm,0.f); mhat+=dl; \
        _Pragma("unroll") for(int r=0;r<16;++r){C0[r]-=dl;C1[r]-=dl;} \
        _Pragma("unroll") for(int r=0;r<16;++r)negm[r]=-mhat; asm volatile("":"+v"(negm)); \
        const float f=__builtin_amdgcn_exp2f(-dl); l_reg*=f; if(hi==0)wsf[r32]=f; resc=true; } } \
    SBAR(); \
    GAPB(o[0]=__builtin_amdgcn_mfma_f32_32x32x16_bf16(PAF(0),VFR(0),o[0],0,0,0), VRD2(0), C0,0); \
    GAPB(o[1]=__builtin_amdgcn_mfma_f32_32x32x16_bf16(PAF(0),VFR(4),o[1],0,0,0), VRD2(4), C0,2); \
    KRD(GL,0); GAPB(o[0]=__builtin_amdgcn_mfma_f32_32x32x16_bf16(PAF(1),VFR(1),o[0],0,0,0), VRD2(1), C0,4); \
    KRD(GL,1); GAPB(o[1]=__builtin_amdgcn_mfma_f32_32x32x16_bf16(PAF(1),VFR(5),o[1],0,0,0), VRD2(5), C0,6); \
    KRD(GL,2); GAPB(o[0]=__builtin_amdgcn_mfma_f32_32x32x16_bf16(PAF(2),VFR(2),o[0],0,0,0), VRD2(2), C0,8); \
    KRD(GL,3); GAPB(o[1]=__builtin_amdgcn_mfma_f32_32x32x16_bf16(PAF(2),VFR(6),o[1],0,0,0), VRD2(6), C0,10); \
    GAPB(o[0]=__builtin_amdgcn_mfma_f32_32x32x16_bf16(PAF(3),VFR(3),o[0],0,0,0), VRD2(3), C0,12); \
    GAPB(o[1]=__builtin_amdgcn_mfma_f32_32x32x16_bf16(PAF(3),VFR(7),o[1],0,0,0), VRD2(7), C0,14); \
    GAPB(o[2]=__builtin_amdgcn_mfma_f32_32x32x16_bf16(PAF(0),VFR(0),o[2],0,0,0), (void)0, C1,0); \
    GAPB(o[3]=__builtin_amdgcn_mfma_f32_32x32x16_bf16(PAF(0),VFR(4),o[3],0,0,0), (void)0, C1,2); \
    GAPB(o[2]=__builtin_amdgcn_mfma_f32_32x32x16_bf16(PAF(1),VFR(1),o[2],0,0,0), (void)0, C1,4); \
    GAPB(o[3]=__builtin_amdgcn_mfma_f32_32x32x16_bf16(PAF(1),VFR(5),o[3],0,0,0), (void)0, C1,6); \
    GAPB(o[2]=__builtin_amdgcn_mfma_f32_32x32x16_bf16(PAF(2),VFR(2),o[2],0,0,0), (void)0, C1,8); \
    GAPB(o[3]=__builtin_amdgcn_mfma_f32_32x32x16_bf16(PAF(2),VFR(6),o[3],0,0,0), (void)0, C1,10); \
    GAPB(o[2]=__builtin_amdgcn_mfma_f32_32x32x16_bf16(PAF(3),VFR(3),o[2],0,0,0), (void)0, C1,12); \
    GAPB(o[3]=__builtin_amdgcn_mfma_f32_32x32x16_bf16(PAF(3),VFR(7),o[3],0,0,0), (void)0, C1,14); \
    }while(0)
  int t=1;
  #undef CMASK
  #define CMASK(P0,P1,t) do{}while(0)
  for(;t+5<NT;t+=2){
    STEP(pB0,pB1,pA0,pA1,t,true,true,true);     WAIT_BAR(3); RESC(); ROT();
    STEP(pA0,pA1,pB0,pB1,t+1,true,true,true);   WAIT_BAR(3); RESC(); ROT();
  }
  #undef CMASK
  #define CMASK(P0,P1,t) do{int jb_=(t)-(NT-4); if(jb_>=0)cmask(P0,P1,jb_,qrel,hi);}while(0)
  #define ENDW(tt) do{ if((tt)+3<NT){WAIT_BAR(3);} else if((tt)+2<NT){WAIT_BAR(2);} else {WAIT_BAR(0);} }while(0)
  for(;t+1<NT;t+=2){
    STEP(pB0,pB1,pA0,pA1,t,(t+3<NT),(t+1<NT),(t+1<NT));       ENDW(t);   RESC(); ROT();
    STEP(pA0,pA1,pB0,pB1,t+1,(t+4<NT),(t+2<NT),(t+2<NT));     ENDW(t+1); RESC(); ROT();
  }
  STEP(pB0,pB1,pA0,pA1,NT-1,false,false,false); RESC();
  { float sacc=pB0[0]+pB0[1]; _Pragma("unroll") for(int r=2;r<16;++r)sacc+=pB0[r]; _Pragma("unroll") for(int r=0;r<16;++r)sacc+=pB1[r]; l_reg+=sacc;
    pw0=(u32x4){PKW(pB0,0),PKW(pB0,2),PKW(pB0,4),PKW(pB0,6)};pw1=(u32x4){PKW(pB0,8),PKW(pB0,10),PKW(pB0,12),PKW(pB0,14)};pw2=(u32x4){PKW(pB1,0),PKW(pB1,2),PKW(pB1,4),PKW(pB1,6)};pw3=(u32x4){PKW(pB1,8),PKW(pB1,10),PKW(pB1,12),PKW(pB1,14)};
    SBAR(); pv(o,vb0+2*sl_cur,PAF(0),PAF(1),PAF(2),PAF(3)); }
  #undef PKW
  #undef PAF
  #undef VFR
  #undef PIN
  #undef MX3
  #undef GAPA
  #undef GAPB
  #undef EX
  #undef VRD
  #undef KRD
  #undef STEP
  #undef ENDW
  {auto rr=__builtin_amdgcn_permlane32_swap(__float_as_uint(l_reg),__float_as_uint(l_reg),false,false);l_reg=__uint_as_float(rr[0])+__uint_as_float(rr[1]);}
  if(hi==0)wsf[32+r32]=l_reg;asm volatile("s_waitcnt lgkmcnt(0)":::"memory");
  float rli[16];
  #pragma unroll
  for(int r=0;r<16;++r)rli[r]=__builtin_amdgcn_rcpf(wsf[32+crow(r,hi)]);
  bf16*Ow=O+(rowbase+q0+wid*QBLK)*OPITCH+ocol;
  { bf16*stg=(bf16*)(shm+LDS_OST)+wid*4096;
    #pragma unroll
    for(int r=0;r<16;++r){const int orow=crow(r,hi);
      #pragma unroll
      for(int d0=0;d0<4;++d0)stg[orow*128+d0*32+r32]=__float2bfloat16(o[d0][r]*rli[r]);}
    asm volatile("s_waitcnt lgkmcnt(0)":::"memory");
    if(!fuse){
      #pragma unroll
      for(int i=0;i<8;++i){const int row=i*4+(lane>>4),ch=lane&15; const u32x4 v=*(const u32x4*)(stg+row*128+ch*8); ATTN_STORE16(Ow+(long)row*OPITCH+ch*8,v);}
    } else {
      const int ch=lane&15; const bf16*O1w=Ow-128; bf16*OCw=OC+(rowbase+q0+wid*QBLK)*DM+occol;
      const float lamf=__uint_as_float(__builtin_amdgcn_readfirstlane(lamf_bits)), oscale=__uint_as_float(__builtin_amdgcn_readfirstlane(oscale_bits));
      asm volatile("s_waitcnt vmcnt(0)":::"memory");
      u32x4 a1[8];
      #pragma unroll
      for(int i=0;i<8;++i){const int row=i*4+(lane>>4); a1[i]=*(const u32x4*)(O1w+(long)row*OPITCH+ch*8);}
      const float4 gA=*(const float4*)(subln+ch*8), gB=*(const float4*)(subln+ch*8+4);
      #pragma unroll
      for(int i=0;i<8;++i){const int row=i*4+(lane>>4); const u32x4 v2=*(const u32x4*)(stg+row*128+ch*8); const u32x4 v1=a1[i];
        float x[8];
        x[0]=__uint_as_float(v1[0]<<16)-lamf*__uint_as_float(v2[0]<<16); x[1]=__uint_as_float(v1[0]&0xffff0000u)-lamf*__uint_as_float(v2[0]&0xffff0000u);
        x[2]=__uint_as_float(v1[1]<<16)-lamf*__uint_as_float(v2[1]<<16); x[3]=__uint_as_float(v1[1]&0xffff0000u)-lamf*__uint_as_float(v2[1]&0xffff0000u);
        x[4]=__uint_as_float(v1[2]<<16)-lamf*__uint_as_float(v2[2]<<16); x[5]=__uint_as_float(v1[2]&0xffff0000u)-lamf*__uint_as_float(v2[2]&0xffff0000u);
        x[6]=__uint_as_float(v1[3]<<16)-lamf*__uint_as_float(v2[3]<<16); x[7]=__uint_as_float(v1[3]&0xffff0000u)-lamf*__uint_as_float(v2[3]&0xffff0000u);
        float ss=(x[0]*x[0]+x[1]*x[1])+(x[2]*x[2]+x[3]*x[3])+(x[4]*x[4]+x[5]*x[5])+(x[6]*x[6]+x[7]*x[7]);
        ss+=__int_as_float(__builtin_amdgcn_update_dpp(0,__float_as_int(ss),0x128,0xf,0xf,false)); ss+=__int_as_float(__builtin_amdgcn_update_dpp(0,__float_as_int(ss),0x124,0xf,0xf,false));
        ss+=__int_as_float(__builtin_amdgcn_update_dpp(0,__float_as_int(ss),0x122,0xf,0xf,false)); ss+=__int_as_float(__builtin_amdgcn_update_dpp(0,__float_as_int(ss),0x121,0xf,0xf,false));
        const float rs=__builtin_amdgcn_rsqf(ss*(1.0f/128.0f)+1e-5f)*oscale;
        u32x4 w; w[0]=cvtpk_s(x[0]*gA.x*rs,x[1]*gA.y*rs); w[1]=cvtpk_s(x[2]*gA.z*rs,x[3]*gA.w*rs); w[2]=cvtpk_s(x[4]*gB.x*rs,x[5]*gB.y*rs); w[3]=cvtpk_s(x[6]*gB.z*rs,x[7]*gB.w*rs);
        *(u32x4*)(OCw+(long)row*DM+ch*8)=w; }
    } }
  asm volatile("s_waitcnt lgkmcnt(0)\n\ts_barrier":::"memory");
  #undef DMA_K
  #undef DMA_V
  #undef CMASK
  #undef START
  #undef RESC
  #undef ROT
}
constexpr int ATTN_LDS_BYTES=LDS_BYTES;
#undef SBAR
#undef WAIT_BAR
}
#ifndef STAGGER_ON
#define STAGGER_ON 0
#endif
#ifndef STAGGER_OUT
#define STAGGER_OUT 600
#endif
#ifndef STAGGER_DOWN
#define STAGGER_DOWN 1400
#endif
#ifndef PG8_ALIGN_EPI
#define PG8_ALIGN_EPI true
#endif
#ifndef PG8_SP2
#define PG8_SP2 true
#endif
namespace cg = cooperative_groups;
constexpr int NWAVES = 8;
constexpr int BATCH = 32, SEQ = 2048, D = 1024, M = BATCH * SEQ, DFF = 2816, GW = 1536;
constexpr size_t MiB = 1u << 20;
constexpr size_t WS_W_ATT_IN = 1 * MiB, WS_W_ATT_OUT = 13 * MiB, WS_W_G_IN = 17 * MiB, WS_W_G_OUT = 23 * MiB, WS_W_C_IN = 26 * MiB, WS_W_C_OUT = 32 * MiB, WS_W_GU = 34 * MiB, WS_W_DN = 78 * MiB, WS_WSB = 100 * MiB;
constexpr size_t WS_ROPE = 101 * MiB, WS_SSQ = 117 * MiB, WS_VSTAT = 121 * MiB, WS_XB = 133 * MiB, WS_ARENA = 261 * MiB, WS_END = 901 * MiB;
constexpr size_t AR_Q = 0, AR_K = 128 * MiB, AR_V = 256 * MiB, AR_O = 384 * MiB;
constexpr size_t AR_U = 0, AR_GV = 192 * MiB, AR_UV = 384 * MiB;
constexpr size_t AR_GB = 0, AR_HC = 128 * MiB, AR_Y = 256 * MiB;
constexpr size_t AR_H = 0;
constexpr int LDS_BYTES = 147456;

#define GAS __attribute__((address_space(1)))
#define LAS __attribute__((address_space(3)))
typedef unsigned short bf16;
typedef unsigned v4u __attribute__((ext_vector_type(4)));
typedef unsigned v2u __attribute__((ext_vector_type(2)));
typedef float f32x4 __attribute__((ext_vector_type(4)));
typedef float f32x2 __attribute__((ext_vector_type(2)));
typedef short bf16x8 __attribute__((ext_vector_type(8)));
typedef short s16x4 __attribute__((ext_vector_type(4)));
#define LDS_WAIT() asm volatile("s_waitcnt lgkmcnt(0)" ::: "memory")
#define VM_WAIT() asm volatile("s_waitcnt vmcnt(0)" ::: "memory")
__device__ __forceinline__ unsigned f2bf(float f) { unsigned u = __builtin_bit_cast(unsigned, f); return (u + 0x7fffu + ((u >> 16) & 1u)) >> 16; }
__device__ __forceinline__ unsigned pk2(float lo, float hi) { return f2bf(lo) | (f2bf(hi) << 16); }
__device__ __forceinline__ float bflo(unsigned w) { return __uint_as_float(w << 16); }
__device__ __forceinline__ float bfhi(unsigned w) { return __uint_as_float(w & 0xffff0000u); }
__device__ __forceinline__ float wave_sum(float v) {
    v += __int_as_float(__builtin_amdgcn_update_dpp(0, __float_as_int(v), 0x128, 0xf, 0xf, false)); v += __int_as_float(__builtin_amdgcn_update_dpp(0, __float_as_int(v), 0x124, 0xf, 0xf, false));
    v += __int_as_float(__builtin_amdgcn_update_dpp(0, __float_as_int(v), 0x122, 0xf, 0xf, false)); v += __int_as_float(__builtin_amdgcn_update_dpp(0, __float_as_int(v), 0x121, 0xf, 0xf, false));
    { const auto a = __builtin_amdgcn_permlane16_swap(__float_as_uint(v), __float_as_uint(v), false, false); v = __uint_as_float(a[0]) + __uint_as_float(a[1]); }
    { const auto b = __builtin_amdgcn_permlane32_swap(__float_as_uint(v), __float_as_uint(v), false, false); v = __uint_as_float(b[0]) + __uint_as_float(b[1]); }
    return v;
}

struct Params { const void* in[21]; float* out; unsigned char* ws; float lam0, lam1; };

__device__ __forceinline__ void p0_item(const float* W, int K, int N, bf16* WT, const float* gain, int kind, LAS float* scr, int item, int lane) {
    const int nblk = N / 32, kb = item / nblk, nb = item % nblk, k0 = 64 * kb, n0 = 32 * nb;
    int d0 = n0;
    if (kind == 1) { if (n0 < 2048) { const int part = n0 >> 10, head = (n0 >> 6) & 15, half = (n0 >> 5) & 1; d0 = (part * 4 + (head >> 2)) * 256 + half * 128 + (head & 3) * 32; } }
    else if (kind == 2) { if (n0 < 2816) d0 = (n0 >> 7) * 256 + (n0 & 127); else { const int j = n0 - 2816; d0 = (j >> 7) * 256 + 128 + (j & 127); } }
    else if (kind == 3) { if (n0 >= 2048) { const int j = n0 - 2048; d0 = 1024 + (j >> 7) * 256 + 128 + (j & 127); } else if (n0 >= 1024) { const int j = n0 - 1024; d0 = 1024 + (j >> 7) * 256 + (j & 127); } }
    f32x4 wv[8];
#pragma unroll
    for (int i = 0; i < 8; ++i) { const int kk = 8 * i + (lane >> 3); wv[i] = *(const f32x4*)(W + (size_t)(k0 + kk) * N + n0 + (lane & 7) * 4); }
#pragma unroll
    for (int i = 0; i < 8; ++i) { const int kk = 8 * i + (lane >> 3); const float gk = gain ? gain[k0 + kk] : 1.0f; LAS float* d = scr + kk * 33 + (lane & 7) * 4;
        d[0] = wv[i][0] * gk; d[1] = wv[i][1] * gk; d[2] = wv[i][2] * gk; d[3] = wv[i][3] * gk; }
    LDS_WAIT(); asm volatile("" ::: "memory");
    const int c = lane & 7;
#pragma unroll
    for (int j = 0; j < 4; ++j) { const int n = (lane >> 3) + 8 * j; const LAS float* s = scr + (8 * c) * 33 + n;
        v4u o; o.x = pk2(s[0 * 33], s[1 * 33]); o.y = pk2(s[2 * 33], s[3 * 33]); o.z = pk2(s[4 * 33], s[5 * 33]); o.w = pk2(s[6 * 33], s[7 * 33]);
        *(v4u*)(WT + (size_t)(d0 + n) * K + k0 + 8 * c) = o; }
    LDS_WAIT(); asm volatile("" ::: "memory");
}

typedef const __attribute__((address_space(4))) unsigned char* kaptr_t;
#define KIN(k) ((const float*)(const float __attribute__((address_space(1)))*)(*(const unsigned long long __attribute__((address_space(4)))*)(ka + 8 * (k))))
#define KOUT ((float*)(float __attribute__((address_space(1)))*)(*(const unsigned long long __attribute__((address_space(4)))*)(ka + 168)))
#define KWS ((unsigned char*)(unsigned char __attribute__((address_space(1)))*)(*(const unsigned long long __attribute__((address_space(4)))*)(ka + 176)))
#define KLAM(jj) (*(const float __attribute__((address_space(4)))*)(ka + 184 + 4 * (jj)))
#define LAUNDER() do { asm volatile("" : "+s"(ka)); asm volatile("" : "+v"(tid)); tid &= 511; } while (0)
#define WSPTRS() unsigned char* const ws = KWS; bf16* const XB = (bf16*)(ws + WS_XB); float* const SSQ = (float*)(ws + WS_SSQ); unsigned char* const AR = ws + WS_ARENA; (void)XB; (void)SSQ; (void)AR

#define XB_TMO      128
#define XB_XCNT(j)  (256  + 64 * (j))
#define XB_XSUB(j)  (1280 + 64 * (j))
#define XB_XGEN(j)  (2304 + 64 * (j))
#define XB_TOP      3328
#define XB_TOPGEN   3392
#define XCD_BAR_WORDS 3456
#define XB_SPIN_CAP (1u << 18)

__device__ __forceinline__ unsigned xb_ld(unsigned* p)              { return __hip_atomic_load(p, __ATOMIC_RELAXED, __HIP_MEMORY_SCOPE_AGENT); }
__device__ __forceinline__ unsigned xb_add(unsigned* p, unsigned v) { return __hip_atomic_fetch_add(p, v, __ATOMIC_RELAXED, __HIP_MEMORY_SCOPE_AGENT); }
__device__ __forceinline__ unsigned xb_xcc_id() { return (unsigned)__builtin_amdgcn_s_getreg((3 << 11) | 20) & 0xFu; }
#define XB_SPIN(cond, bar) do { unsigned _sp = 0; while (cond) { __builtin_amdgcn_s_sleep(1); \
    if ((++_sp & 255u) == 0u) { if (xb_ld(&(bar)[XB_TMO])) break; if (_sp > XB_SPIN_CAP) { atomicAdd(&(bar)[XB_TMO], 1u); break; } } } } while (0)

struct XcdBarrier {
    unsigned* bar; unsigned x;
    volatile LAS unsigned* st;
};

__device__ __forceinline__ XcdBarrier xcd_barrier_post(unsigned* bar, volatile LAS unsigned* st) {
    XcdBarrier b; b.bar = bar; b.x = xb_xcc_id(); b.st = st;
    if (threadIdx.x == 0) (void)xb_add(&bar[XB_XCNT(b.x)], 1u);
    return b;
}
__device__ __forceinline__ void xcd_barrier_complete(unsigned* bar, unsigned x, unsigned& nloc, unsigned& nx) {
    const unsigned G = gridDim.x * gridDim.y * gridDim.z;
    unsigned sum, cnt, mine, sp = 0u;
    for (;;) {
        sum = 0u; cnt = 0u; mine = 0u;
#pragma unroll
        for (unsigned j = 0; j < 16; ++j) { const unsigned c = xb_ld(&bar[XB_XCNT(j)]); sum += c; cnt += (c > 0u) ? 1u : 0u; mine = (j == x) ? c : mine; }
        if (sum == G) break;
        __builtin_amdgcn_s_sleep(1);
        if ((++sp & 255u) == 0u) { if (xb_ld(&bar[XB_TMO])) break; if (sp > XB_SPIN_CAP) { atomicAdd(&bar[XB_TMO], 1u); break; } }
    }
    nloc = mine > 0u ? mine : 1u; nx = cnt > 0u ? cnt : 1u;
}

__device__ __forceinline__ void xcd_barrier(const XcdBarrier& b) {
    asm volatile("s_waitcnt vmcnt(0)" ::: "memory");
    __syncthreads();
    if (threadIdx.x == 0) {
        unsigned* bar = b.bar;
        __builtin_amdgcn_s_waitcnt(0);
        unsigned nloc = b.st[0], nx = b.st[1];
        if (nloc == 0u) { xcd_barrier_complete(bar, b.x, nloc, nx); b.st[0] = nloc; b.st[1] = nx; }
        const unsigned old = xb_add(&bar[XB_XSUB(b.x)], 1u);
        const unsigned gen = old / nloc;
        if (old + 1u == (gen + 1u) * nloc) {
            __builtin_amdgcn_fence(__ATOMIC_RELEASE, "agent");
            asm volatile("s_waitcnt vmcnt(0)" ::: "memory");
            const unsigned og = xb_add(&bar[XB_TOP], 1u);
            const unsigned tg = og / nx;
            if (og + 1u == (tg + 1u) * nx) xb_add(&bar[XB_TOPGEN], 1u);
            else XB_SPIN(xb_ld(&bar[XB_TOPGEN]) == tg, bar);
            __builtin_amdgcn_fence(__ATOMIC_ACQUIRE, "agent");
            xb_add(&bar[XB_XGEN(b.x)], 1u);
            asm volatile("s_waitcnt vmcnt(0)" ::: "memory");
        } else {
            XB_SPIN(xb_ld(&bar[XB_XGEN(b.x)]) == gen, bar);
            __builtin_amdgcn_fence(__ATOMIC_ACQUIRE, "agent");
            asm volatile("s_waitcnt vmcnt(0)" ::: "memory");
        }
    }
    __syncthreads();
}

__device__ __forceinline__ void light_step(const int step, kaptr_t& ka, int& tid, LAS unsigned char* const L, const int G, const int bx, const int vcu) {
        const int layer = step / 5, stage = step % 5, kind = layer % 3, j = layer / 3;
        LAUNDER(); WSPTRS();
        const int lane = tid & 63, wave = __builtin_amdgcn_readfirstlane(tid >> 6); (void)lane; (void)wave;
        if (stage != 1) {
            pg8::Gemm g; pg8::EpiGen E;
            float* const out = KOUT;
            g.M = M; E.ssq = SSQ; E.eps = 1e-6f; E.o0 = nullptr; E.o1 = nullptr; E.o2 = nullptr; E.pos = (const int*)KIN(1); E.bias = KIN(10); E.vstat = (pg8::f32x2e*)(ws + WS_VSTAT); E.xout = nullptr; E.xb = XB;
            if (stage == 0) {
                g.A = XB; g.K = 1024; g.N = 3072;
                if (kind == 0) { g.Bt = (const bf16*)(ws + WS_W_ATT_IN) + (size_t)j * 3145728; E.mode = 0; E.o0 = (bf16*)(AR + AR_Q); E.o1 = (bf16*)(AR + AR_K); E.o2 = (bf16*)(AR + AR_V); }
                else if (kind == 1) { g.Bt = (const bf16*)(ws + WS_W_G_IN); E.mode = 1; E.o0 = (bf16*)(AR + AR_U); E.o1 = (bf16*)(AR + AR_GV); }
                else { g.Bt = (const bf16*)(ws + WS_W_C_IN); E.mode = 2; E.o0 = (bf16*)(AR + AR_GB); E.o1 = (bf16*)(AR + AR_HC); }
            } else if (stage == 2) {
                g.N = 1024; E.mode = 3; E.o0 = XB;
                if (kind == 0) { g.A = (const bf16*)(AR + AR_Q); g.Bt = (const bf16*)(ws + WS_W_ATT_OUT) + (size_t)j * 1048576; g.K = 1024; }
                else if (kind == 1) { g.A = (const bf16*)(AR + AR_UV); g.Bt = (const bf16*)(ws + WS_W_G_OUT); g.K = 1536; }
                else { g.A = (const bf16*)(AR + AR_Y); g.Bt = (const bf16*)(ws + WS_W_C_OUT); g.K = 1024; }
            } else if (stage == 3) {
                g.A = XB; g.Bt = (const bf16*)(ws + WS_W_GU) + (size_t)layer * 5767168; g.N = 5632; g.K = 1024; E.mode = 4; E.o0 = (bf16*)(AR + AR_H);
            } else {
                g.A = (const bf16*)(AR + AR_H); g.Bt = (const bf16*)(ws + WS_W_DN) + (size_t)layer * 2883584; g.N = 1024; g.K = 2816; E.mode = 3; E.o0 = XB;
            }
            pg8::StaticOrder S; S.init(g.M, g.N, G, bx);
            if (E.mode == 3 && STAGGER_ON) {
                const unsigned long long dl = (unsigned long long)(bx >> 6) * (stage == 2 ? STAGGER_OUT : STAGGER_DOWN);
                const unsigned long long t0_ = __builtin_amdgcn_s_memrealtime(); while (__builtin_amdgcn_s_memrealtime() - t0_ < dl) __builtin_amdgcn_s_sleep(4);
            }
            pg8::gemm_phase<pg8::EpiGen, pg8::StaticOrder, PG8_ALIGN_EPI, PG8_SP2>(L, g, S, E, tid);
        } else if (kind == 1) {
            const bf16* U = (const bf16*)(AR + AR_U); const bf16* GV = (const bf16*)(AR + AR_GV); bf16* UV = (bf16*)(AR + AR_UV);
            constexpr int SP_RS = 784;
            LAS f32x2* stat = (LAS f32x2*)(L + 128 * SP_RS); const f32x2* VSTAT = (const f32x2*)(ws + WS_VSTAT); const bf16* WSB = (const bf16*)(ws + WS_WSB);
            const float* gmlp_ln_g = KIN(11); const float* gmlp_ln_b = KIN(12); const float* gmlp_b_s = KIN(14);
            const int fr = lane & 15, fq = lane >> 4;
            const int cgp = tid % 48, rsl = tid / 48;
            for (int unit = vcu; unit < 2048; unit += G) {
                const int chunk = unit >> 2, gp = unit & 3; const size_t row0 = (size_t)chunk * 128;
                const int c = gp * 384 + cgp * 8;
                const f32x4 ga = *(const f32x4*)(gmlp_ln_g + c), gb = *(const f32x4*)(gmlp_ln_g + c + 4), ba = *(const f32x4*)(gmlp_ln_b + c), bb = *(const f32x4*)(gmlp_ln_b + c + 4);
                __syncthreads();
                if (tid < 128) {
                    const f32x4* ps = (const f32x4*)(VSTAT + (row0 + tid) * 24); float s1 = 0.f, s2 = 0.f;
#pragma unroll
                    for (int i = 0; i < 12; ++i) { const f32x4 q = ps[i]; s1 += q[0] + q[2]; s2 += q[1] + q[3]; }
                    const float mean = s1 * (1.0f / 1536.0f); const float var = fmaxf(s2 * (1.0f / 1536.0f) - mean * mean, 0.f);
                    stat[tid] = (f32x2){mean, __builtin_amdgcn_rsqf(var + 1e-5f)};
                }
                v4u raw[13];
#pragma unroll
                for (int i = 0; i < 13; ++i) { const int r = rsl + 10 * i; raw[i] = *(const v4u*)(GV + (row0 + (r < 128 ? r : 127)) * 1536 + c); }
                __syncthreads();
#pragma unroll
                for (int i = 0; i < 13; ++i) {
                    const int r = rsl + 10 * i;
                    if (tid < 480 && r < 128) {
                        const f32x2 st = stat[r];
                        f32x4 v0 = (f32x4){bflo(raw[i].x), bfhi(raw[i].x), bflo(raw[i].y), bfhi(raw[i].y)}, v1 = (f32x4){bflo(raw[i].z), bfhi(raw[i].z), bflo(raw[i].w), bfhi(raw[i].w)};
                        v0 = (v0 - st.x) * st.y * ga + ba; v1 = (v1 - st.x) * st.y * gb + bb;
                        *(LAS v4u*)(L + r * SP_RS + cgp * 16) = (v4u){pk2(v0[0], v0[1]), pk2(v0[2], v0[3]), pk2(v1[0], v1[1]), pk2(v1[2], v1[3])};
                    }
                }
                __syncthreads();
                const int t = 16 * wave + fr; const int nk = (wave >> 1) + 1;
                for (int gi = 0; gi < 2; ++gi) {
                    const int gg = 2 * gp + gi;
                    f32x4 acc[12];
#pragma unroll
                    for (int n = 0; n < 12; ++n) acc[n] = (f32x4){0.f, 0.f, 0.f, 0.f};
                    for (int kk = 0; kk < nk; ++kk) {
                        const bf16x8 wsf = *(const bf16x8*)(WSB + ((size_t)gg * 128 + t) * 128 + 32 * kk + 8 * fq);
                        const LAS unsigned char* tb = L + (32 * kk + 8 * fq + ((lane >> 2) & 3)) * SP_RS + gi * 384 + (lane & 3) * 8;
#pragma unroll
                        for (int n = 0; n < 12; ++n) {
                            const s16x4 lo = __builtin_bit_cast(s16x4, __builtin_amdgcn_ds_read_tr16_b64_v4i16((LAS s16x4*)(tb + n * 32)));
                            const s16x4 hi = __builtin_bit_cast(s16x4, __builtin_amdgcn_ds_read_tr16_b64_v4i16((LAS s16x4*)(tb + n * 32 + 4 * SP_RS)));
                            const bf16x8 vf = (bf16x8){lo[0], lo[1], lo[2], lo[3], hi[0], hi[1], hi[2], hi[3]};
                            acc[n] = __builtin_amdgcn_mfma_f32_16x16x32_bf16(vf, wsf, acc[n], 0, 0, 0);
                        }
                    }
                    const float bs = gmlp_b_s[gg * 128 + t];
                    v2u uv_[12];
#pragma unroll
                    for (int n = 0; n < 12; ++n) uv_[n] = *(const v2u*)(U + (row0 + t) * 1536 + gg * 192 + 16 * n + 4 * fq);
#pragma unroll
                    for (int n = 0; n < 12; ++n) {
                        const size_t o = (row0 + t) * 1536 + gg * 192 + 16 * n + 4 * fq;
                        const v2u uu = uv_[n];
                        const f32x4 sv = acc[n] + bs;
                        *(v2u*)(UV + o) = (v2u){pk2(bflo(uu.x) * sv[0], bfhi(uu.x) * sv[1]), pk2(bflo(uu.y) * sv[2], bfhi(uu.y) * sv[3])};
                    }
                }
            }
        } else {
            const float* conv_w = KIN(17);
            const bf16* GBp = (const bf16*)(AR + AR_GB); const bf16* HC = (const bf16*)(AR + AR_HC); bf16* Y = (bf16*)(AR + AR_Y);
            const int gt = vcu * (NWAVES * 64) + tid, NGT = G * NWAVES * 64;
            for (int it = gt; it < (M / 8) * 128; it += NGT) {
                const int cgp = it & 127, rb = it >> 7, c = cgp * 8; const size_t t0 = (size_t)rb * 8;
                const f32x4 w0a = *(const f32x4*)(conv_w + c), w0b = *(const f32x4*)(conv_w + c + 4), w1a = *(const f32x4*)(conv_w + 1024 + c), w1b = *(const f32x4*)(conv_w + 1024 + c + 4), w2a = *(const f32x4*)(conv_w + 2048 + c), w2b = *(const f32x4*)(conv_w + 2048 + c + 4);
                f32x4 m2a = (f32x4){0.f, 0.f, 0.f, 0.f}, m2b = m2a, m1a = m2a, m1b = m2a;
                if ((t0 & (SEQ - 1)) != 0) {
                    const v4u r2 = *(const v4u*)(HC + (t0 - 2) * 1024 + c), r1 = *(const v4u*)(HC + (t0 - 1) * 1024 + c);
                    m2a = (f32x4){bflo(r2.x), bfhi(r2.x), bflo(r2.y), bfhi(r2.y)}; m2b = (f32x4){bflo(r2.z), bfhi(r2.z), bflo(r2.w), bfhi(r2.w)};
                    m1a = (f32x4){bflo(r1.x), bfhi(r1.x), bflo(r1.y), bfhi(r1.y)}; m1b = (f32x4){bflo(r1.z), bfhi(r1.z), bflo(r1.w), bfhi(r1.w)};
                }
                v4u hrv[8], grv[8];
#pragma unroll
                for (int r = 0; r < 8; ++r) { hrv[r] = *(const v4u*)(HC + (t0 + r) * 1024 + c); grv[r] = *(const v4u*)(GBp + (t0 + r) * 1024 + c); }
#pragma unroll
                for (int r = 0; r < 8; ++r) {
                    const v4u hr = hrv[r], gr = grv[r];
                    const f32x4 ha = (f32x4){bflo(hr.x), bfhi(hr.x), bflo(hr.y), bfhi(hr.y)}, hb = (f32x4){bflo(hr.z), bfhi(hr.z), bflo(hr.w), bfhi(hr.w)};
                    const f32x4 ga = (f32x4){bflo(gr.x), bfhi(gr.x), bflo(gr.y), bfhi(gr.y)}, gb = (f32x4){bflo(gr.z), bfhi(gr.z), bflo(gr.w), bfhi(gr.w)};
                    const f32x4 ya = ga * (w0a * m2a + w1a * m1a + w2a * ha), yb = gb * (w0b * m2b + w1b * m1b + w2b * hb);
                    *(v4u*)(Y + (t0 + r) * 1024 + c) = (v4u){pk2(ya[0], ya[1]), pk2(ya[2], ya[3]), pk2(yb[0], yb[1]), pk2(yb[2], yb[3])};
                    m2a = m1a; m2b = m1b; m1a = ha; m1b = hb;
                }
            }
        }
}

__device__ __forceinline__ void attn_step(const int j, kaptr_t& ka, int& tid, char* const ldsg, const int G, const int vcu) {
        LAUNDER(); WSPTRS();
        {
            const attn_body::bf16* Q = (const attn_body::bf16*)(AR + AR_Q); const attn_body::bf16* Kp = (const attn_body::bf16*)(AR + AR_K); const attn_body::bf16* Vp = (const attn_body::bf16*)(AR + AR_V);
            attn_body::bf16* O = (attn_body::bf16*)(AR + AR_O);
            const float lam_init = KLAM(j); const float* attn_lambda = KIN(6); const float* attn_subln = KIN(7);
            const float* lam = attn_lambda + j * 256; const int lane0 = tid & 63;
            const float la = wave_sum(lam[lane0] * lam[64 + lane0]), lb = wave_sum(lam[128 + lane0] * lam[192 + lane0]);
            const unsigned lamf_bits = __builtin_amdgcn_readfirstlane(__float_as_uint(__expf(la) - __expf(lb) + lam_init)), oscale_bits = __builtin_amdgcn_readfirstlane(__float_as_uint(1.0f - lam_init));
            for (int bh = vcu; bh < BATCH * 8; bh += G) {
                const int b = bh >> 3, h = bh & 7;
                for (int ui = 0; ui < 16; ++ui) {
                    const int qb = 7 - (ui >> 1), map = ui & 1;
                    attn_body::attn_unit<8>(b, 2 * h + map, h * 128, h * 256 + map * 128, qb, Q, Kp, Vp, O, ldsg, tid, map == 1, lamf_bits, oscale_bits, attn_subln + j * 128, (attn_body::bf16*)(AR + AR_Q), h * 128);
                }
            }
        }
}

#ifndef PROBE_MASK
#define PROBE_MASK 0u
#endif
__global__ void __launch_bounds__(NWAVES * 64, 2) trunk_fwd(Params p) {
    extern __shared__ __attribute__((aligned(16))) unsigned char lds[];
    cg::grid_group grid = cg::this_grid();
    LAS unsigned char* const L = (LAS unsigned char*)lds;
    const int G = gridDim.x; const int bx = blockIdx.x; const int vcu = (G % 8 == 0) ? (bx % 8) * (G / 8) + bx / 8 : bx;
    kaptr_t ka = (kaptr_t)__builtin_amdgcn_kernarg_segment_ptr();
    int tid = threadIdx.x;

#if PROBE_MASK
    unsigned long long* const TS = (unsigned long long*)KWS;
#define STAMP(k) do { if (blockIdx.x == 0 && threadIdx.x == 0) TS[(k)] = __builtin_amdgcn_s_memrealtime(); } while (0)
#else
#define STAMP(k) do { } while (0)
#endif
    STAMP(0);
#ifdef PROBE_DELAY
    { const unsigned long long t0_ = __builtin_amdgcn_s_memrealtime(); while (__builtin_amdgcn_s_memrealtime() - t0_ < (unsigned long long)PROBE_DELAY) __builtin_amdgcn_s_sleep(8); }
#endif
    {
        LAUNDER(); WSPTRS();
        const int lane = tid & 63, wave = __builtin_amdgcn_readfirstlane(tid >> 6);
        const float* x_in = KIN(0); const float* mix_norm = KIN(2); const float* ffn_norm = KIN(3);
        const float* attn_w_in = KIN(5); const float* attn_w_out = KIN(8); const float* gmlp_w_in = KIN(9); const float* gmlp_w_s = KIN(13); const float* gmlp_w_out = KIN(15);
        const float* conv_w_in = KIN(16); const float* conv_w_out = KIN(18); const float* ffn_w_gu = KIN(19); const float* ffn_w_dn = KIN(20);
        bf16* const W_ATT_IN = (bf16*)(ws + WS_W_ATT_IN); bf16* const W_ATT_OUT = (bf16*)(ws + WS_W_ATT_OUT); bf16* const W_G_IN = (bf16*)(ws + WS_W_G_IN); bf16* const W_G_OUT = (bf16*)(ws + WS_W_G_OUT);
        bf16* const W_C_IN = (bf16*)(ws + WS_W_C_IN); bf16* const W_C_OUT = (bf16*)(ws + WS_W_C_OUT); bf16* const W_GU = (bf16*)(ws + WS_W_GU); bf16* const W_DN = (bf16*)(ws + WS_W_DN); bf16* const WSB = (bf16*)(ws + WS_WSB);
        LAS float* scr = (LAS float*)(L + wave * 16384);
        const int gw = vcu * NWAVES + wave, NGW = G * NWAVES;
        constexpr int I_AIN = 16 * 96, I_AOUT = 16 * 32, I_GOUT = 24 * 32, I_GU = 16 * 176, I_DN = 44 * 32;
        constexpr int NITEMS = 2 * I_AIN + 2 * I_AOUT + I_AIN + I_GOUT + I_AIN + I_AOUT + 4 * I_GU + 4 * I_DN;
        for (int it = gw; it < NITEMS; it += NGW) {
            int r = it;
            if (r < 2 * I_AIN) { const int j = r / I_AIN; p0_item(attn_w_in + (size_t)j * 3145728, 1024, 3072, W_ATT_IN + (size_t)j * 3145728, mix_norm + (j ? 3 : 0) * 1024, 1, scr, r % I_AIN, lane); continue; } r -= 2 * I_AIN;
            if (r < 2 * I_AOUT) { const int j = r / I_AOUT; p0_item(attn_w_out + (size_t)j * 1048576, 1024, 1024, W_ATT_OUT + (size_t)j * 1048576, nullptr, 0, scr, r % I_AOUT, lane); continue; } r -= 2 * I_AOUT;
            if (r < I_AIN) { p0_item(gmlp_w_in, 1024, 3072, W_G_IN, mix_norm + 1024, 0, scr, r, lane); continue; } r -= I_AIN;
            if (r < I_GOUT) { p0_item(gmlp_w_out, 1536, 1024, W_G_OUT, nullptr, 0, scr, r, lane); continue; } r -= I_GOUT;
            if (r < I_AIN) { p0_item(conv_w_in, 1024, 3072, W_C_IN, mix_norm + 2048, 3, scr, r, lane); continue; } r -= I_AIN;
            if (r < I_AOUT) { p0_item(conv_w_out, 1024, 1024, W_C_OUT, nullptr, 0, scr, r, lane); continue; } r -= I_AOUT;
            if (r < 4 * I_GU) { const int j = r / I_GU; p0_item(ffn_w_gu + (size_t)j * 5767168, 1024, 5632, W_GU + (size_t)j * 5767168, ffn_norm + j * 1024, 2, scr, r % I_GU, lane); continue; } r -= 4 * I_GU;
            { const int j = r / I_DN; p0_item(ffn_w_dn + (size_t)j * 2883584, 2816, 1024, W_DN + (size_t)j * 2883584, nullptr, 0, scr, r % I_DN, lane); }
        }
        const int gt = vcu * (NWAVES * 64) + tid, NGT = G * NWAVES * 64;
        for (int i = gt; i < 8 * 128 * 128; i += NGT) { const int s = i & 127, t = (i >> 7) & 127; WSB[i] = (s <= t) ? (bf16)f2bf(gmlp_w_s[i]) : (bf16)0; }
        for (int m0 = gw * 4; m0 < M; m0 += NGW * 4) {
            f32x4 v[4][4]; float s[4];
#pragma unroll
            for (int r = 0; r < 4; ++r) { const f32x4* xr = (const f32x4*)(x_in + (size_t)(m0 + r) * D) + lane;
#pragma unroll
                for (int j = 0; j < 4; ++j) v[r][j] = xr[64 * j]; }
#pragma unroll
            for (int r = 0; r < 4; ++r) { float a = 0.f;
#pragma unroll
                for (int j = 0; j < 4; ++j) a += (v[r][j][0] * v[r][j][0] + v[r][j][1] * v[r][j][1]) + (v[r][j][2] * v[r][j][2] + v[r][j][3] * v[r][j][3]);
                s[r] = wave_sum(a);
                v2u* o8 = (v2u*)(XB + (size_t)(m0 + r) * D) + lane;
#pragma unroll
                for (int j = 0; j < 4; ++j) o8[64 * j] = (v2u){pk2(v[r][j][0], v[r][j][1]), pk2(v[r][j][2], v[r][j][3])};
                if (lane < 16) SSQ[(size_t)(m0 + r) * 16 + lane] = (lane == 0) ? s[r] : 0.f; }
        }
    }
    unsigned* const barw = (unsigned*)(KWS + 65536);
    if (blockIdx.x == 0) for (int i_ = threadIdx.x; i_ < XCD_BAR_WORDS; i_ += NWAVES * 64) barw[i_] = 0u;
    volatile LAS unsigned* const bst = (volatile LAS unsigned*)(L + LDS_BYTES - 16);
    if (threadIdx.x < 2) bst[threadIdx.x] = 0u;
    grid.sync(); STAMP(1);
    (void)xcd_barrier_post(barw, bst);
#define GSYNC() do { XcdBarrier b_; b_.bar = (unsigned*)(KWS + 65536); b_.x = xb_xcc_id(); b_.st = (volatile LAS unsigned*)(L + LDS_BYTES - 16); xcd_barrier(b_); } while (0)
#ifdef PROBE_NSYNC
    for (int i_ = 0; i_ < PROBE_NSYNC; ++i_) grid.sync();
#endif

#ifndef DBG_NO_LIGHT
    light_step(0, ka, tid, L, G, bx, vcu); GSYNC(); STAMP(2);
#endif
#ifndef DBG_NO_ATTN
    attn_step(0, ka, tid, (char*)lds, G, vcu); GSYNC(); STAMP(3);
#endif
#ifndef DBG_NO_LIGHT
    for (int step = 2; step < 16; ++step) { light_step(step, ka, tid, L, G, bx, vcu); GSYNC(); STAMP(2 + step); }
#endif
#ifndef DBG_NO_ATTN2
    attn_step(1, ka, tid, (char*)lds, G, vcu); GSYNC(); STAMP(18);
#endif
#ifndef DBG_NO_LIGHT
    for (int step = 17; step < 20; ++step) { light_step(step, ka, tid, L, G, bx, vcu); GSYNC(); STAMP(2 + step); }
#endif
#if PROBE_MASK
    grid.sync();
#endif

#if PROBE_MASK
#error "timing-probe builds are not supported with the bf16-fed final norm"
#endif
    {
        LAUNDER();
        const int lane = tid & 63, wave = __builtin_amdgcn_readfirstlane(tid >> 6); float* const out = KOUT; const float* final_norm = KIN(4); const bf16* XBf = (const bf16*)(KWS + WS_XB);
        const int gw = vcu * NWAVES + wave, NGW = G * NWAVES;
        f32x4 gn[2][2];
#pragma unroll
        for (int jj = 0; jj < 2; ++jj) { gn[jj][0] = *(const f32x4*)(final_norm + 512 * jj + 8 * lane); gn[jj][1] = *(const f32x4*)(final_norm + 512 * jj + 8 * lane + 4); }
        for (int m0 = gw * 4; m0 < M; m0 += NGW * 4) {
            v4u w[4][2];
#pragma unroll
            for (int r = 0; r < 4; ++r)
#pragma unroll
                for (int jj = 0; jj < 2; ++jj) w[r][jj] = *(const v4u*)(XBf + (size_t)(m0 + r) * D + 512 * jj + 8 * lane);
#pragma unroll
            for (int r = 0; r < 4; ++r) {
                f32x4 v[2][2]; float s = 0.f;
#pragma unroll
                for (int jj = 0; jj < 2; ++jj) { const v4u q = w[r][jj];
                    v[jj][0] = (f32x4){bflo(q.x), bfhi(q.x), bflo(q.y), bfhi(q.y)}; v[jj][1] = (f32x4){bflo(q.z), bfhi(q.z), bflo(q.w), bfhi(q.w)};
                    s += (v[jj][0][0] * v[jj][0][0] + v[jj][0][1] * v[jj][0][1]) + (v[jj][0][2] * v[jj][0][2] + v[jj][0][3] * v[jj][0][3]) + (v[jj][1][0] * v[jj][1][0] + v[jj][1][1] * v[jj][1][1]) + (v[jj][1][2] * v[jj][1][2] + v[jj][1][3] * v[jj][1][3]); }
                const float rs = __builtin_amdgcn_rsqf(wave_sum(s) * (1.0f / 1024.0f) + 1e-6f);
                float* o = out + (size_t)(m0 + r) * D + 8 * lane;
#pragma unroll
                for (int jj = 0; jj < 2; ++jj) { *(f32x4*)(o + 512 * jj) = v[jj][0] * rs * gn[jj][0]; *(f32x4*)(o + 512 * jj + 4) = v[jj][1] * rs * gn[jj][1]; }
            }
        }
    }
}

extern "C" void kernel_launch(void* const* d_in, const int* in_sizes, int n_in, void* d_out, int out_size, void* d_ws, size_t ws_size, hipStream_t stream) {
    static int grid = 0;
    if (grid == 0) {
        if (n_in != 21 || in_sizes[0] != M * D || out_size != M * D || ws_size < WS_END) { fprintf(stderr, "kernel_launch: unexpected shapes (n_in %d, in0 %d, out %d, ws %zu)\n", n_in, n_in > 0 ? in_sizes[0] : -1, out_size, ws_size); grid = -1; return; }
        int dev = 0, cus = 0, per_cu = 0;
        if (hipGetDevice(&dev) != hipSuccess || hipDeviceGetAttribute(&cus, hipDeviceAttributeMultiprocessorCount, dev) != hipSuccess) { grid = -1; return; }
        if (hipFuncSetAttribute((const void*)trunk_fwd, hipFuncAttributeMaxDynamicSharedMemorySize, LDS_BYTES) != hipSuccess) { fprintf(stderr, "kernel_launch: hipFuncSetAttribute failed\n"); grid = -1; return; }
        if (hipOccupancyMaxActiveBlocksPerMultiprocessor(&per_cu, (const void*)trunk_fwd, NWAVES * 64, LDS_BYTES) != hipSuccess || per_cu < 1) { fprintf(stderr, "kernel_launch: occupancy query says %d\n", per_cu); per_cu = 1; }
        (void)hipGetLastError();
        grid = cus;
    }
    if (grid < 0) return;
    Params p{};
    for (int i = 0; i < 21; ++i) p.in[i] = d_in[i];
    p.out = (float*)d_out; p.ws = (unsigned char*)d_ws;
    p.lam0 = (float)(0.8 - 0.6 * exp(-0.3 * 0.0)); p.lam1 = (float)(0.8 - 0.6 * exp(-0.3 * 3.0));
    void* args[] = {&p};
    const hipError_t e = hipLaunchCooperativeKernel((const void*)trunk_fwd, dim3(grid), dim3(NWAVES * 64), args, LDS_BYTES, stream);
    if (e != hipSuccess) fprintf(stderr, "kernel_launch: cooperative launch failed: %s (grid %d)\n", hipGetErrorString(e), grid);
}
```
